# Optimizing an MI355X kernel written in HIP

```python
import jax, jax.numpy as jnp
from jax import lax
import numpy as np

D_MODEL = 1024
BATCH = 8
SEQ = 8192
DEPTH = 1

CHUNK = 64
N_LEFT_CHUNKS = 8
A_HEADS = 8
A_HEAD_DIM = 64
A_WIDTH = A_HEADS * A_HEAD_DIM
REL_CLIP = 128
R_HEADS = 8
R_KEY_DIM = 64
R_VAL_DIM = 128
R_QK_WIDTH = R_HEADS * R_KEY_DIM
R_V_WIDTH = R_HEADS * R_VAL_DIM
ROPE_BASE = 10000.0
NORM_EPS = 1e-6
GN_EPS = 1e-5
NEG_INF = -1e30
IN_SPLITS = (A_WIDTH, A_WIDTH, A_WIDTH, A_WIDTH, R_QK_WIDTH, R_QK_WIDTH, R_V_WIDTH, R_V_WIDTH, D_MODEL, D_MODEL)
IN_WIDTH = 4 * A_WIDTH + 2 * R_QK_WIDTH + 2 * R_V_WIDTH + 2 * D_MODEL

kernel_name = "hybrid_chunk_attn_retention_gated"


def rms_norm(x, gain):
    xf = x.astype(jnp.float32)
    y = xf * lax.rsqrt(jnp.mean(xf * xf, axis=-1, keepdims=True) + NORM_EPS)
    return (y * gain.astype(jnp.float32)).astype(x.dtype)


def split_columns(proj):
    outs = []
    start = 0
    for width in IN_SPLITS:
        outs.append(proj[..., start:start + width])
        start += width
    return outs


def rotary(x, positions):
    half = x.shape[-1] // 2
    inv_freq = jnp.power(ROPE_BASE, -jnp.arange(half, dtype=jnp.float32) / half)
    ang = positions.astype(jnp.float32)[:, None] * inv_freq[None, :]
    cos = jnp.cos(ang)[None, :, None, :]
    sin = jnp.sin(ang)[None, :, None, :]
    x1 = x[..., :half].astype(jnp.float32)
    x2 = x[..., half:].astype(jnp.float32)
    out = jnp.concatenate([x1 * cos - x2 * sin, x1 * sin + x2 * cos], axis=-1)
    return out.astype(x.dtype)


def chunk_band_attention(q, k, v, rel_bias):
    B, S, H, d = q.shape
    n_chunks = S // CHUNK
    band = (N_LEFT_CHUNKS + 1) * CHUNK
    q_local = jnp.arange(CHUNK)
    p = jnp.arange(band)
    dist = q_local[:, None] + N_LEFT_CHUNKS * CHUNK - p[None, :]
    idx = jnp.clip(dist, -REL_CLIP, REL_CLIP) + REL_CLIP
    bias = rel_bias[:, idx].astype(jnp.float32)
    valid = (jnp.arange(n_chunks)[:, None] - N_LEFT_CHUNKS + p[None, :] // CHUNK) >= 0
    scale = d ** -0.5

    def one_sequence(args):
        qb, kb, vb = args
        qc = qb.reshape(n_chunks, CHUNK, H, d)
        pad = jnp.zeros((N_LEFT_CHUNKS, CHUNK, H, d), kb.dtype)
        kp = jnp.concatenate([pad, kb.reshape(n_chunks, CHUNK, H, d)], axis=0)
        vp = jnp.concatenate([pad, vb.reshape(n_chunks, CHUNK, H, d)], axis=0)
        k_band = jnp.concatenate([kp[i:i + n_chunks] for i in range(N_LEFT_CHUNKS + 1)], axis=1)
        v_band = jnp.concatenate([vp[i:i + n_chunks] for i in range(N_LEFT_CHUNKS + 1)], axis=1)
        s = jnp.einsum('nqhd,nkhd->nhqk', qc, k_band).astype(jnp.float32) * scale + bias[None]
        s = jnp.where(valid[:, None, None, :], s, NEG_INF)
        w = jax.nn.softmax(s, axis=-1).astype(vb.dtype)
        o = jnp.einsum('nhqk,nkhd->nqhd', w, v_band)
        return o.reshape(S, H, d)

    return lax.map(one_sequence, (q, k, v))


def retention_chunkwise(q, k, v, gn_gain):
    B, S, H, dk = q.shape
    dv = v.shape[-1]
    n_chunks = S // CHUNK
    log_gamma = jnp.log1p(-jnp.exp2(-5.0 - jnp.arange(H, dtype=jnp.float32)))
    j = jnp.arange(CHUNK, dtype=jnp.float32)
    intra_decay = jnp.exp(jnp.abs(j[:, None] - j[None, :])[None] * log_gamma[:, None, None])
    cross_decay = jnp.exp((j + 1.0)[None, :] * log_gamma[:, None])
    state_decay = jnp.exp((CHUNK - 1.0 - j)[None, :] * log_gamma[:, None])
    chunk_decay = jnp.exp(CHUNK * log_gamma)

    qc = q.reshape(B, n_chunks, CHUNK, H, dk) * (dk ** -0.5)
    kc = k.reshape(B, n_chunks, CHUNK, H, dk)
    vc = v.reshape(B, n_chunks, CHUNK, H, dv)

    s = jnp.einsum('bnqhd,bnkhd->bnhqk', qc, kc) * intra_decay
    o_intra = jnp.einsum('bnhqk,bnkhe->bnqhe', s, vc)

    kv = jnp.einsum('bnkhd,hk,bnkhe->nbhde', kc, state_decay, vc).astype(jnp.float32)

    def step(state, kv_n):
        return state * chunk_decay[None, :, None, None] + kv_n, state

    _, state_prev = lax.scan(step, jnp.zeros((B, H, dk, dv), jnp.float32), kv)
    o_cross = jnp.einsum('bnqhd,nbhde->bnqhe', qc, state_prev) * cross_decay.T[:, :, None]

    o = (o_intra + o_cross).astype(jnp.float32).reshape(B, S, H, dv)
    mean = jnp.mean(o, axis=-1, keepdims=True)
    var = jnp.mean(jnp.square(o - mean), axis=-1, keepdims=True)
    o = (o - mean) * lax.rsqrt(var + GN_EPS)
    o = o.reshape(B, S, H * dv) * gn_gain.astype(jnp.float32)
    return o.astype(v.dtype)


def setup_inputs(seed: int = 0) -> dict:
    key = jax.random.key(seed)
    ks = jax.random.split(key, 10)
    x = jax.random.normal(ks[0], (BATCH, SEQ, D_MODEL), jnp.float32)
    norm_gain = 1.0 + 0.01 * jax.random.normal(ks[1], (DEPTH, D_MODEL), jnp.float32)
    w_in = jax.random.normal(ks[2], (DEPTH, D_MODEL, IN_WIDTH), jnp.float32) * D_MODEL ** -0.5
    rel_bias = 0.5 * jax.random.normal(ks[3], (DEPTH, A_HEADS, 2 * REL_CLIP + 1), jnp.float32)
    gn_gain = 1.0 + 0.01 * jax.random.normal(ks[4], (DEPTH, R_V_WIDTH), jnp.float32)
    w_out_attn = jax.random.normal(ks[5], (DEPTH, A_WIDTH, D_MODEL), jnp.float32) * A_WIDTH ** -0.5
    w_out_ret = jax.random.normal(ks[6], (DEPTH, R_V_WIDTH, D_MODEL), jnp.float32) * R_V_WIDTH ** -0.5
    w_out = jax.random.normal(ks[7], (DEPTH, D_MODEL, D_MODEL), jnp.float32) * D_MODEL ** -0.5
    final_gain = 1.0 + 0.01 * jax.random.normal(ks[8], (D_MODEL,), jnp.float32)
    return {"x": x, "norm_gain": norm_gain, "w_in": w_in, "rel_bias": rel_bias,
            "gn_gain": gn_gain, "w_out_attn": w_out_attn, "w_out_ret": w_out_ret,
            "w_out": w_out, "final_gain": final_gain}


def reference(x, norm_gain, w_in, rel_bias, gn_gain, w_out_attn, w_out_ret, w_out, final_gain):
    B, S, _ = x.shape
    positions = jnp.arange(S)
    for l in range(DEPTH):
        h = rms_norm(x, norm_gain[l])
        proj = jnp.einsum('bsd,df->bsf', h, w_in[l])
        q_a, k_a, v_a, g_a, q_r, k_r, v_r, g_r, m_a, m_r = split_columns(proj)

        o_a = chunk_band_attention(q_a.reshape(B, S, A_HEADS, A_HEAD_DIM),
                                   k_a.reshape(B, S, A_HEADS, A_HEAD_DIM),
                                   v_a.reshape(B, S, A_HEADS, A_HEAD_DIM),
                                   rel_bias[l]).reshape(B, S, A_WIDTH)
        branch_a = jnp.einsum('bsf,fd->bsd', o_a * jax.nn.silu(g_a), w_out_attn[l])

        qr = rotary(q_r.reshape(B, S, R_HEADS, R_KEY_DIM), positions)
        kr = rotary(k_r.reshape(B, S, R_HEADS, R_KEY_DIM), positions)
        o_r = retention_chunkwise(qr, kr, v_r.reshape(B, S, R_HEADS, R_VAL_DIM), gn_gain[l])
        branch_r = jnp.einsum('bsf,fd->bsd', o_r * jax.nn.silu(g_r), w_out_ret[l])

        mixed = jax.nn.sigmoid(m_a) * branch_a + jax.nn.sigmoid(m_r) * branch_r
        x = x + jnp.einsum('bsd,de->bse', mixed, w_out[l]).astype(x.dtype)
    return rms_norm(x, final_gain)
```

```cpp
#include <hip/hip_runtime.h>
#include <cstdio>
#include <cstdint>

__device__ __forceinline__ int lane_id_asm() { int l_; asm volatile("v_mbcnt_lo_u32_b32 %0, -1, 0\n\tv_mbcnt_hi_u32_b32 %0, -1, %0" : "=v"(l_)); return l_; }
namespace pg8 {
#define PG8_LAS __attribute__((address_space(3)))
typedef unsigned short bf16_t;
typedef short bf16x8 __attribute__((ext_vector_type(8)));
typedef float f32x4 __attribute__((ext_vector_type(4)));
typedef unsigned u32x4 __attribute__((ext_vector_type(4)));
typedef unsigned u32x2 __attribute__((ext_vector_type(2)));
constexpr int BM = 256, BK = 64, HALF = 128, HTB = HALF * BK * 2  , STAGE_BYTES = 8 * HTB, NXCD = 8, WGM = 8;

__host__ __device__ __forceinline__ int lds_byte(int r, int c) { const int st = (r >> 4) * 2 + (c >> 5), rr = r & 15, cc = c & 31, ob = rr * 64 + cc * 2; return st * 1024 + (ob ^ (((ob >> 9) & 1) << 5)); }
__host__ __device__ __forceinline__ void stage_rc(int b, int& R, int& C) { const int st = b / 1024, sb = b % 1024, swz = sb ^ (((sb >> 9) & 1) << 5); R = (st >> 1) * 16 + swz / 64; C = (st & 1) * 32 + (swz % 64) / 2; }
__host__ __device__ __forceinline__ int perm32(int rho) { const int n = rho >> 4, i = rho & 15; return 8 * (i >> 2) + 4 * n + (i & 3); }

struct Unit { int pm, pn; };
struct Gemm { const bf16_t* A; const bf16_t* Bt; int M, N, K, lda, ldb; };

struct StaticOrder {
    int nM, nN, nwg, G, c;
    __host__ __device__ void init(int M, int N, int G_, int c_) { nM = M / BM; nN = N / BM; nwg = nM * nN; G = G_; c = c_; }
    __host__ __device__ bool next(int i, Unit& u) const {
        const long L = (long)i * G + c; if (L >= nwg) return false;
        int wgid = (int)L; { const int q = nwg / NXCD, r = nwg % NXCD, xcd = wgid % NXCD, off = wgid / NXCD; wgid = (xcd < r ? xcd * (q + 1) : r * (q + 1) + (xcd - r) * q) + off; }
        const int nig = WGM * nN, gid = wgid / nig, fm = gid * WGM, gsz = (nM - fm) < WGM ? (nM - fm) : WGM;
        u.pm = fm + ((wgid % nig) % gsz); u.pn = (wgid % nig) / gsz; return true;
    }
    __device__ __forceinline__ void a_ready(const Unit&) const {}
    __device__ __forceinline__ void done(const Unit&) const {}
};

typedef float f32x2_cv __attribute__((ext_vector_type(2))); typedef __bf16 bf16x2_cv __attribute__((ext_vector_type(2)));
__device__ __forceinline__ unsigned cvt_pk_bf16(float lo, float hi) { f32x2_cv v = {lo, hi}; bf16x2_cv b = __builtin_convertvector(v, bf16x2_cv); return __builtin_bit_cast(unsigned, b); }
__device__ __forceinline__ float bf_lo(unsigned w) { return __uint_as_float(w << 16); }
__device__ __forceinline__ float bf_hi(unsigned w) { return __uint_as_float(w & 0xffff0000u); }

template <class Epi, class Sched, bool ALIGN_EPI = false, bool SP2 = false>
__device__ __forceinline__ void gemm_phase(PG8_LAS unsigned char* lds, const Gemm g, const Sched& S, const Epi& E, int wave_id) {
    const int tid_ = (__builtin_amdgcn_readfirstlane(wave_id) << 6) | lane_id_asm();
    const int tid = tid_, wid = __builtin_amdgcn_readfirstlane(tid >> 6), lane = tid & 63, wr = wid >> 2, wc = wid & 3, fr = lane & 15, fq = lane >> 4;
    const int K = g.K, nt = K / BK;
    unsigned voffA[2], voffB[2];
#pragma unroll
    for (int i = 0; i < 2; ++i) { int R, C; stage_rc(tid * 16 + i * 8192, R, C); const int Rb = Epi::PERM ? ((R & ~31) + perm32(R & 31)) : R;
        voffA[i] = (unsigned)(R * g.lda + C) * 2u; voffB[i] = (unsigned)(Rb * g.ldb + C) * 2u; }
    const size_t kstep = (size_t)(BK * 2);
    const size_t hstepA = (size_t)HALF * g.lda * 2, hstepB = (size_t)HALF * g.ldb * 2;
    const size_t tstepA = 2 * hstepA, tstepB = 2 * hstepB;
    const unsigned ldsw = (unsigned)wid * 1024u;
    const int aoff = lds_byte(wr * 64 + fr, fq * 8), boff = lds_byte(wc * 32 + fr, fq * 8);
#define PG8_SA(b, h) (((b) * 2 + (h)) * HTB)
#define PG8_SB(b, h) ((4 + (b) * 2 + (h)) * HTB)
    const unsigned lds_b0 = (unsigned)__builtin_amdgcn_readfirstlane((int)(unsigned)(unsigned long long)lds) + ldsw;
#define PG8_STAGE(bufoff, gbase, voff) do { _Pragma("unroll") for (int _i = 0; _i < 2; ++_i) \
        asm volatile("s_mov_b32 m0, %1\n\ts_nop 0\n\tglobal_load_lds_dwordx4 %0, off" :: "v"((const char*)(gbase) + (voff)[_i]), "s"(lds_b0 + (unsigned)(bufoff) + (unsigned)(_i * 8192)) : "memory"); } while (0)
#define PG8_LDA(dst, b, h) do { _Pragma("unroll") for (int m = 0; m < 4; ++m) _Pragma("unroll") for (int k = 0; k < 2; ++k) dst[m][k] = *(const PG8_LAS bf16x8*)(lds + PG8_SA(b, h) + aoff + m * 2048 + k * 1024); } while (0)
#define PG8_LDB(dst, b, h) do { _Pragma("unroll") for (int n = 0; n < 2; ++n) _Pragma("unroll") for (int k = 0; k < 2; ++k) dst[n][k] = *(const PG8_LAS bf16x8*)(lds + PG8_SB(b, h) + boff + n * 2048 + k * 1024); } while (0)
#define PG8_MMA(ai, bj, At, Bt) do { __builtin_amdgcn_s_setprio(1); _Pragma("unroll") for (int m = 0; m < 4; ++m) _Pragma("unroll") for (int n = 0; n < 2; ++n) _Pragma("unroll") for (int k = 0; k < 2; ++k) \
        acc[ai][bj][m][n] = __builtin_amdgcn_mfma_f32_16x16x32_bf16(Bt[n][k], At[m][k], acc[ai][bj][m][n], 0, 0, 0); __builtin_amdgcn_s_setprio(0); } while (0)
#define PG8_WAIT_V(n) asm volatile("s_waitcnt vmcnt(" #n ")" ::: "memory")
#define PG8_WAIT_L(n) asm volatile("s_waitcnt lgkmcnt(" #n ")" ::: "memory")
#define PG8_BAR __builtin_amdgcn_s_barrier()
#define PG8_SCHED __builtin_amdgcn_sched_barrier(0)
    Unit cur, nxt; int ui = 0;
    if (!S.next(0, cur)) return;
    f32x4 acc[2][2][4][2];
#pragma unroll
    for (int a = 0; a < 2; ++a)
#pragma unroll
        for (int b = 0; b < 2; ++b)
#pragma unroll
            for (int m = 0; m < 4; ++m)
#pragma unroll
                for (int n = 0; n < 2; ++n) acc[a][b][m][n] = (f32x4){0.f, 0.f, 0.f, 0.f};
    bf16x8 At[4][2], B0[2][2], B1[2][2];
    const char* cA = (const char*)g.A + (size_t)cur.pm * tstepA; const char* cB = (const char*)g.Bt + (size_t)cur.pn * tstepB;
    S.a_ready(cur);
    if constexpr (SP2) {
        PG8_STAGE(PG8_SB(0, 0), cB, voffB); PG8_STAGE(PG8_SB(0, 1), cB + hstepB, voffB); PG8_STAGE(PG8_SA(0, 0), cA, voffA); PG8_STAGE(PG8_SA(0, 1), cA + hstepA, voffA);
        if (wr == 1) PG8_BAR;
        PG8_WAIT_V(2); PG8_BAR;
        PG8_STAGE(PG8_SB(1, 0), cB + kstep, voffB); PG8_STAGE(PG8_SA(1, 0), cA + kstep, voffA); PG8_STAGE(PG8_SB(1, 1), cB + hstepB + kstep, voffB);
        PG8_WAIT_V(6); PG8_BAR;
    } else {
        PG8_STAGE(PG8_SB(0, 0), cB, voffB); PG8_STAGE(PG8_SA(0, 0), cA, voffA); PG8_STAGE(PG8_SB(0, 1), cB + hstepB, voffB); PG8_STAGE(PG8_SA(0, 1), cA + hstepA, voffA);
        if (wr == 1) PG8_BAR;
        PG8_WAIT_V(4); PG8_BAR;
        PG8_STAGE(PG8_SB(1, 0), cB + kstep, voffB); PG8_STAGE(PG8_SA(1, 0), cA + kstep, voffA); PG8_STAGE(PG8_SB(1, 1), cB + hstepB + kstep, voffB);
        PG8_WAIT_V(6); PG8_BAR;
    }
    for (;;) {
        const bool has_next = S.next(ui + 1, nxt);
        const char* nA = has_next ? (const char*)g.A + (size_t)nxt.pm * tstepA : cA; const char* nB = has_next ? (const char*)g.Bt + (size_t)nxt.pn * tstepB : cB;
        for (int t = 0; t < nt; t += 2) {
            if constexpr (Epi::MID_T > 0) { if (t == Epi::MID_T) E.mid(acc, cur, wr, wc, fr, fq); }
            const bool last = (t == nt - 2);
            const char* a1 = cA + (size_t)(t + 1) * kstep;
            const char* a2 = last ? nA : cA + (size_t)(t + 2) * kstep; const char* b2 = last ? nB : cB + (size_t)(t + 2) * kstep;
            const char* a3 = a2 + kstep; const char* b3 = b2 + kstep;
            if (last && has_next) S.a_ready(nxt);
            if constexpr (SP2) {
            PG8_LDB(B0, 0, 0); PG8_LDB(B1, 0, 1); PG8_SCHED; PG8_LDA(At, 0, 0); PG8_STAGE(PG8_SA(1, 1), a1 + hstepA, voffA);
            PG8_WAIT_V(8); PG8_WAIT_L(0); PG8_BAR; PG8_MMA(0, 0, At, B0); PG8_MMA(0, 1, At, B1); PG8_BAR; PG8_SCHED;
            PG8_LDA(At, 0, 1); PG8_STAGE(PG8_SB(0, 0), b2, voffB); PG8_STAGE(PG8_SB(0, 1), b2 + hstepB, voffB); PG8_STAGE(PG8_SA(0, 0), a2, voffA);
            PG8_WAIT_V(8); PG8_WAIT_L(0); PG8_BAR; PG8_MMA(1, 0, At, B0); PG8_MMA(1, 1, At, B1); PG8_BAR; PG8_SCHED;
            PG8_LDB(B0, 1, 0); PG8_LDB(B1, 1, 1); PG8_SCHED; PG8_LDA(At, 1, 0); PG8_STAGE(PG8_SA(0, 1), a2 + hstepA, voffA);
            PG8_WAIT_V(8); PG8_WAIT_L(0); PG8_BAR; PG8_MMA(0, 0, At, B0); PG8_MMA(0, 1, At, B1); PG8_BAR; PG8_SCHED;
            PG8_LDA(At, 1, 1); PG8_STAGE(PG8_SB(1, 0), b3, voffB); PG8_STAGE(PG8_SB(1, 1), b3 + hstepB, voffB); PG8_STAGE(PG8_SA(1, 0), a3, voffA);
            PG8_WAIT_V(8); PG8_WAIT_L(0); PG8_BAR; PG8_MMA(1, 0, At, B0); PG8_MMA(1, 1, At, B1); PG8_BAR; PG8_SCHED;
            } else {
            PG8_LDB(B0, 0, 0); PG8_SCHED; PG8_LDA(At, 0, 0); PG8_STAGE(PG8_SA(1, 1), a1 + hstepA, voffA);
            PG8_WAIT_L(8); PG8_BAR; PG8_WAIT_L(0); PG8_MMA(0, 0, At, B0); PG8_BAR; PG8_SCHED;
            PG8_LDB(B1, 0, 1); PG8_STAGE(PG8_SB(0, 0), b2, voffB);
            PG8_BAR; PG8_WAIT_L(0); PG8_MMA(0, 1, At, B1); PG8_BAR;
            PG8_LDA(At, 0, 1); PG8_STAGE(PG8_SA(0, 0), a2, voffA);
            PG8_BAR; PG8_WAIT_L(0); PG8_MMA(1, 0, At, B0); PG8_BAR; PG8_SCHED;
            PG8_STAGE(PG8_SB(0, 1), b2 + hstepB, voffB);
            PG8_WAIT_V(6); PG8_BAR; PG8_MMA(1, 1, At, B1); PG8_BAR;
            PG8_LDB(B0, 1, 0); PG8_SCHED; PG8_LDA(At, 1, 0); PG8_STAGE(PG8_SA(0, 1), a2 + hstepA, voffA);
            PG8_WAIT_L(8); PG8_BAR; PG8_WAIT_L(0); PG8_MMA(0, 0, At, B0); PG8_BAR; PG8_SCHED;
            PG8_LDB(B1, 1, 1); PG8_STAGE(PG8_SB(1, 0), b3, voffB);
            PG8_BAR; PG8_WAIT_L(0); PG8_MMA(0, 1, At, B1); PG8_BAR;
            PG8_LDA(At, 1, 1); PG8_STAGE(PG8_SA(1, 0), a3, voffA);
            PG8_BAR; PG8_WAIT_L(0); PG8_MMA(1, 0, At, B0); PG8_BAR; PG8_SCHED;
            PG8_STAGE(PG8_SB(1, 1), b3 + hstepB, voffB);
            PG8_WAIT_V(6); PG8_BAR; PG8_MMA(1, 1, At, B1); PG8_BAR;
            }
        }
        if constexpr (ALIGN_EPI) { if (wr == 0) PG8_BAR; }
        if constexpr (!Epi::AFTER_DRAIN) { E(acc, cur, wr, wc, fr, fq); S.done(cur); }
        if (!has_next) break;
#pragma unroll
        for (int a = 0; a < 2; ++a)
#pragma unroll
            for (int b = 0; b < 2; ++b)
#pragma unroll
                for (int m = 0; m < 4; ++m)
#pragma unroll
                    for (int n = 0; n < 2; ++n) acc[a][b][m][n] = (f32x4){0.f, 0.f, 0.f, 0.f};
        cur = nxt; cA = nA; cB = nB; ++ui;
        if constexpr (ALIGN_EPI) { if (wr == 1) PG8_BAR; }
    }
    PG8_WAIT_V(0);
    if constexpr (!ALIGN_EPI) { if (wr == 0) PG8_BAR; }
    PG8_BAR;
    if constexpr (Epi::AFTER_DRAIN) { E.fused(acc, cur, wr, wc, fr, fq, lds, wid, lane); S.done(cur); }
#undef PG8_SA
#undef PG8_SB
#undef PG8_STAGE
#undef PG8_LDA
#undef PG8_LDB
#undef PG8_MMA
#undef PG8_WAIT_V
#undef PG8_WAIT_L
#undef PG8_BAR
#undef PG8_SCHED
}
}

typedef unsigned short bf16;
typedef float f32x4 __attribute__((ext_vector_type(4)));
typedef unsigned u32x4 __attribute__((ext_vector_type(4)));
typedef unsigned u32x2 __attribute__((ext_vector_type(2)));
#define LAS __attribute__((address_space(3)))
constexpr int BATCH = 8, SEQ = 8192, DM = 1024, T = BATCH * SEQ, NIN = 7168, NCH = SEQ / 64;
constexpr int AW = 512, RQK = 512, RVW = 1024, KCAT = 1536;
constexpr float C2 = 0.18033688011112042f;
constexpr float LOG2E = 1.4426950408889634f;
constexpr size_t MiB = 1u << 20;
constexpr size_t WS_CTL = 0, WS_WIN = 1 * MiB, WS_WCAT = 16 * MiB, WS_WO = 20 * MiB;
constexpr size_t WS_H = 24 * MiB, WS_ACAT = 152 * MiB;
constexpr size_t WS_QR = 344 * MiB, WS_KDR = 408 * MiB, WS_VR = 472 * MiB, WS_GR = 600 * MiB, WS_ST = 728 * MiB;
constexpr size_t WS_QA = 344 * MiB, WS_KA = 408 * MiB, WS_VA = 472 * MiB, WS_GA = 536 * MiB;
constexpr size_t WS_SA = 344 * MiB, WS_SR = 472 * MiB, WS_TMP = 600 * MiB, WS_MIXED = 24 * MiB, WS_END = 856 * MiB;
constexpr int LDS_BYTES = 155648;
constexpr size_t WS_XBUF = 22 * MiB;
constexpr int CW_PANEL = 32768;
constexpr int XCH_OFF = 131072;

__device__ __forceinline__ double rope_rev_freq(int w, int fq, int i) {
    const double f0 = 0.15915494309189535;
    const double a = (w == 0) ? 1.0 : 0.01000000000000001;
    const double b = (fq == 0) ? 1.0 : (fq == 1) ? 0.316227766016838 : (fq == 2) ? 0.10000000000000005 : 0.03162277660168382;
    const double c = (i == 0) ? 1.0 : (i == 1) ? 0.7498942093324559 : (i == 2) ? 0.5623413251903492 : 0.42169650342858234;
    return f0 * a * b * c;
}
__device__ __forceinline__ float log2gamma(int h) {
    const float tb[8] = {-0.04580368961312479f, -0.02272007650008353f, -0.011315313227834146f, -0.005646563141142063f, -0.0028205190623786626f, -0.0014095702546713536f, -0.0007046129765893727f, -0.0003522634716290214f};
    float r = tb[0];
#pragma unroll
    for (int i = 1; i < 8; ++i) r = (h == i) ? tb[i] : r;
    return r;
}

__device__ __forceinline__ float bf2f(unsigned v) { return __uint_as_float(v << 16); }
__device__ __forceinline__ unsigned f2bf(float f) { unsigned u = __float_as_uint(f); return (u + 0x7fffu + ((u >> 16) & 1u)) >> 16; }
__device__ __forceinline__ unsigned pk2(float lo, float hi) { return f2bf(lo) | (f2bf(hi) << 16); }
__device__ __forceinline__ float fast_exp2(float x) { return __builtin_amdgcn_exp2f(x); }
__device__ __forceinline__ float sigmoidf_(float x) { return __builtin_amdgcn_rcpf(1.0f + fast_exp2(-x * LOG2E)); }

struct Epi1 {
    static constexpr bool PERM = true, AFTER_DRAIN = false; static constexpr int MID_T = 0;
    bf16 *QA, *KA, *VA, *GA, *QR, *KDR, *VR, *GR, *SA, *SR; int pn_off; const float* gn;
    template <int MODE> __device__ __forceinline__ void body(const pg8::f32x4 (&acc)[2][2][4][2], const pg8::Unit& u, int wr, int wc, int fr, int fq, bf16* base, int ld, int colt, float sc, int head0) const {
        const int row0 = u.pm * 256 + wr * 64 + fr;
        double fr4[4];
        float l2g[2] = {0.f, 0.f};
        if ((MODE == 3 || MODE == 4)) {
            const int w = wc & 1;
#pragma unroll
            for (int i = 0; i < 4; ++i) fr4[i] = rope_rev_freq(w, fq, i);
            if (MODE == 4) { l2g[0] = log2gamma(head0 + (wc >> 1)); l2g[1] = log2gamma(head0 + 2 + (wc >> 1)); }
        }
#pragma unroll
        for (int ai = 0; ai < 2; ++ai)
#pragma unroll
            for (int m = 0; m < 4; ++m) {
                const int row = row0 + ai * 128 + m * 16;
                float cs[4], sn[4];
                if ((MODE == 3 || MODE == 4)) {
                    const int pos = row & (SEQ - 1);
#pragma unroll
                    for (int i = 0; i < 4; ++i) { double rv = (double)pos * fr4[i]; rv -= __builtin_floor(rv); const float rf = (float)rv; cs[i] = __builtin_amdgcn_cosf(rf); sn[i] = __builtin_amdgcn_sinf(rf); }
                }
#pragma unroll
                for (int bj = 0; bj < 2; ++bj) {
                    pg8::f32x4 v0 = acc[ai][bj][m][0], v1 = acc[ai][bj][m][1];
                    if (MODE == 0) { v0 = v0 * sc; v1 = v1 * sc; }
                    if (MODE == 1 || MODE == 6) {
#pragma unroll
                        for (int i = 0; i < 4; ++i) { v0[i] = v0[i] * sigmoidf_(v0[i]); v1[i] = v1[i] * sigmoidf_(v1[i]); }
                        if (MODE == 6) { const pg8::f32x4 g0 = *(const pg8::f32x4*)(gn + colt + bj * 128 + wc * 32 + 8 * fq), g1 = *(const pg8::f32x4*)(gn + colt + bj * 128 + wc * 32 + 8 * fq + 4); v0 = v0 * g0; v1 = v1 * g1; }
                    }
                    if (MODE == 2) {
#pragma unroll
                        for (int i = 0; i < 4; ++i) { v0[i] = sigmoidf_(v0[i]); v1[i] = sigmoidf_(v1[i]); }
                    }
                    if ((MODE == 3 || MODE == 4)) {
                        float f = 0.125f;
                        if (MODE == 4) f = fast_exp2((float)(63 - (row & 63)) * l2g[bj]);
#pragma unroll
                        for (int i = 0; i < 4; ++i) { const float x1 = v0[i], x2 = v1[i]; v0[i] = (x1 * cs[i] - x2 * sn[i]) * f; v1[i] = (x1 * sn[i] + x2 * cs[i]) * f; }
                    }
                    pg8::u32x4 w; w.x = pg8::cvt_pk_bf16(v0[0], v0[1]); w.y = pg8::cvt_pk_bf16(v0[2], v0[3]); w.z = pg8::cvt_pk_bf16(v1[0], v1[1]); w.w = pg8::cvt_pk_bf16(v1[2], v1[3]);
                    *(pg8::u32x4*)(base + (size_t)row * ld + colt + bj * 128 + wc * 32 + 8 * fq) = w;
                }
            }
    }
    __device__ __forceinline__ void body_gate(const pg8::f32x4 (&acc)[2][2][4][2], const pg8::Unit& u, int wr, int wc, int fr, int fq, int pg) const {
        const int row0 = u.pm * 256 + wr * 64 + fr, col = pg * 128 + wc * 32 + 8 * fq;
#pragma unroll
        for (int ai = 0; ai < 2; ++ai)
#pragma unroll
            for (int m = 0; m < 4; ++m) {
                const size_t off = (size_t)(row0 + ai * 128 + m * 16) * 1024 + col;
                float ra[8], sr[8];
#pragma unroll
                for (int n = 0; n < 2; ++n)
#pragma unroll
                    for (int i = 0; i < 4; ++i) { const float ea = fast_exp2(fminf(-acc[ai][0][m][n][i] * LOG2E, 80.f)), er = fast_exp2(fminf(-acc[ai][1][m][n][i] * LOG2E, 80.f));
                        const float s = __builtin_amdgcn_rcpf(1.0f + er); sr[4 * n + i] = s; ra[4 * n + i] = (1.0f + er) * __builtin_amdgcn_rcpf(1.0f + ea); }
                pg8::u32x4 w; w.x = pg8::cvt_pk_bf16(ra[0], ra[1]); w.y = pg8::cvt_pk_bf16(ra[2], ra[3]); w.z = pg8::cvt_pk_bf16(ra[4], ra[5]); w.w = pg8::cvt_pk_bf16(ra[6], ra[7]);
                *(pg8::u32x4*)(SA + off) = w;
                w.x = pg8::cvt_pk_bf16(sr[0], sr[1]); w.y = pg8::cvt_pk_bf16(sr[2], sr[3]); w.z = pg8::cvt_pk_bf16(sr[4], sr[5]); w.w = pg8::cvt_pk_bf16(sr[6], sr[7]);
                *(pg8::u32x4*)(SR + off) = w;
            }
    }
    __device__ __forceinline__ void operator()(const pg8::f32x4 (&acc)[2][2][4][2], const pg8::Unit& u, int wr, int wc, int fr, int fq) const {
        const int pn = u.pn + pn_off;
        if (pn < 2)        body<0>(acc, u, wr, wc, fr, fq, QA, 512, (pn - 0) * 256, C2, 0);
        else if (pn < 4)   body<0>(acc, u, wr, wc, fr, fq, KA, 512, (pn - 2) * 256, 1.0f, 0);
        else if (pn < 6)   body<0>(acc, u, wr, wc, fr, fq, VA, 512, (pn - 4) * 256, 1.0f, 0);
        else if (pn < 8)   body<1>(acc, u, wr, wc, fr, fq, GA, 512, (pn - 6) * 256, 1.0f, 0);
        else if (pn < 10)  body<3>(acc, u, wr, wc, fr, fq, QR, 512, (pn - 8) * 256, 1.0f, 0);
        else if (pn < 12)  body<4>(acc, u, wr, wc, fr, fq, KDR, 512, (pn - 10) * 256, 1.0f, (pn - 10) * 4);
        else if (pn < 16)  body<0>(acc, u, wr, wc, fr, fq, VR, 1024, (pn - 12) * 256, 1.0f, 0);
        else if (pn < 20)  body<6>(acc, u, wr, wc, fr, fq, GR, 1024, (pn - 16) * 256, 1.0f, 0);
        else               body_gate(acc, u, wr, wc, fr, fq, pn - 20);
    }
};
struct Epi2 {
    static constexpr bool PERM = true, AFTER_DRAIN = false; static constexpr int MID_T = 8;
    const bf16* RATIO; const bf16* SR; bf16* MIXED;
    __device__ __forceinline__ void mid(pg8::f32x4 (&acc)[2][2][4][2], const pg8::Unit& u, int wr, int wc, int fr, int fq) const {
        int fr_ = fr, fq_ = fq; asm volatile("" : "+v"(fr_), "+v"(fq_));
        const int row0 = u.pm * 256 + wr * 64 + fr_, col0 = u.pn * 256 + wc * 32 + 8 * fq_;
#pragma unroll
        for (int ai = 0; ai < 2; ++ai) {
            pg8::u32x4 s[4][2];
#pragma unroll
            for (int m = 0; m < 4; ++m)
#pragma unroll
                for (int bj = 0; bj < 2; ++bj) s[m][bj] = *(const pg8::u32x4*)(RATIO + (size_t)(row0 + ai * 128 + m * 16) * 1024 + col0 + bj * 128);
#pragma unroll
            for (int m = 0; m < 4; ++m)
#pragma unroll
                for (int bj = 0; bj < 2; ++bj) { const pg8::u32x4 q = s[m][bj]; pg8::f32x4& v0 = acc[ai][bj][m][0]; pg8::f32x4& v1 = acc[ai][bj][m][1];
                    v0[0] *= pg8::bf_lo(q.x); v0[1] *= pg8::bf_hi(q.x); v0[2] *= pg8::bf_lo(q.y); v0[3] *= pg8::bf_hi(q.y);
                    v1[0] *= pg8::bf_lo(q.z); v1[1] *= pg8::bf_hi(q.z); v1[2] *= pg8::bf_lo(q.w); v1[3] *= pg8::bf_hi(q.w); }
            __builtin_amdgcn_sched_barrier(0);
        }
    }
    __device__ __forceinline__ void operator()(pg8::f32x4 (&acc)[2][2][4][2], const pg8::Unit& u, int wr, int wc, int fr, int fq) const {
        int fr_ = fr, fq_ = fq; asm volatile("" : "+v"(fr_), "+v"(fq_));
        const int row0 = u.pm * 256 + wr * 64 + fr_, col0 = u.pn * 256 + wc * 32 + 8 * fq_;
#pragma unroll
        for (int ai = 0; ai < 2; ++ai) {
            pg8::u32x4 s[4][2];
#pragma unroll
            for (int m = 0; m < 4; ++m)
#pragma unroll
                for (int bj = 0; bj < 2; ++bj) s[m][bj] = *(const pg8::u32x4*)(SR + (size_t)(row0 + ai * 128 + m * 16) * 1024 + col0 + bj * 128);
#pragma unroll
            for (int m = 0; m < 4; ++m)
#pragma unroll
                for (int bj = 0; bj < 2; ++bj) { const pg8::u32x4 q = s[m][bj]; const pg8::f32x4 v0 = acc[ai][bj][m][0], v1 = acc[ai][bj][m][1];
                    pg8::u32x4 w; w.x = pg8::cvt_pk_bf16(v0[0] * pg8::bf_lo(q.x), v0[1] * pg8::bf_hi(q.x)); w.y = pg8::cvt_pk_bf16(v0[2] * pg8::bf_lo(q.y), v0[3] * pg8::bf_hi(q.y));
                    w.z = pg8::cvt_pk_bf16(v1[0] * pg8::bf_lo(q.z), v1[1] * pg8::bf_hi(q.z)); w.w = pg8::cvt_pk_bf16(v1[2] * pg8::bf_lo(q.w), v1[3] * pg8::bf_hi(q.w));
                    *(pg8::u32x4*)(MIXED + (size_t)(row0 + ai * 128 + m * 16) * 1024 + col0 + bj * 128) = w; }
            __builtin_amdgcn_sched_barrier(0);
        }
    }
};
struct Epi3n {
    static constexpr bool PERM = false, AFTER_DRAIN = false; static constexpr int MID_T = 0;
    const float* X; float* OUT; const float* gain; float* xbuf; unsigned* cnt; LAS unsigned char* lds;
    __device__ __forceinline__ void operator()(pg8::f32x4 (&acc)[2][2][4][2], const pg8::Unit& u, int wr, int wc, int fr, int fq) const {
        int fr_ = fr, fq_ = fq; asm volatile("" : "+v"(fr_), "+v"(fq_));
        const int row0 = u.pm * 256 + wr * 64 + fr_, col0 = u.pn * 256 + wc * 32 + 4 * fq_;
        LAS float* P = (LAS float*)(lds + XCH_OFF); LAS float* S = P + 1024; volatile LAS unsigned* flag = (volatile LAS unsigned*)(S + 256);
        const int wid = wr * 4 + wc, lane = fq_ * 16 + fr_;
#pragma unroll
        for (int ai = 0; ai < 2; ++ai)
#pragma unroll
            for (int mp = 0; mp < 2; ++mp) {
                pg8::f32x4 xv[2][2][2];
#pragma unroll
                for (int mm = 0; mm < 2; ++mm)
#pragma unroll
                    for (int bj = 0; bj < 2; ++bj)
#pragma unroll
                        for (int n = 0; n < 2; ++n) xv[mm][bj][n] = *(const pg8::f32x4*)(X + (size_t)(row0 + ai * 128 + (2 * mp + mm) * 16) * 1024 + col0 + bj * 128 + n * 16);
#pragma unroll
                for (int mm = 0; mm < 2; ++mm) {
                    const int m = 2 * mp + mm; float s = 0.f;
#pragma unroll
                    for (int bj = 0; bj < 2; ++bj)
#pragma unroll
                        for (int n = 0; n < 2; ++n) { const pg8::f32x4 y = xv[mm][bj][n] + acc[ai][bj][m][n]; acc[ai][bj][m][n] = y; s += (y[0] * y[0] + y[1] * y[1]) + (y[2] * y[2] + y[3] * y[3]); }
                    s += __shfl_xor(s, 16); s += __shfl_xor(s, 32);
                    if (fq_ == 0) P[(ai * 128 + wr * 64 + m * 16 + fr_) * 4 + wc] = s;
                }
                __builtin_amdgcn_sched_barrier(0);
            }
        asm volatile("s_waitcnt lgkmcnt(0)\n\ts_barrier" ::: "memory");
        const int prow = wid * 32 + (lane & 31);
        if (lane < 32) {
            const float t = (P[prow * 4 + 0] + P[prow * 4 + 1]) + (P[prow * 4 + 2] + P[prow * 4 + 3]);
            __hip_atomic_store(xbuf + ((size_t)u.pm * 256 + prow) * 4 + u.pn, t, __ATOMIC_RELAXED, __HIP_MEMORY_SCOPE_AGENT);
        }
        asm volatile("s_waitcnt vmcnt(0)" ::: "memory");
        if (lane == 0) __hip_atomic_fetch_add(cnt + 64 * u.pm, 1u, __ATOMIC_RELAXED, __HIP_MEMORY_SCOPE_AGENT);
        if (wid == 0) {
            unsigned spins = 0;
            while ((unsigned)__builtin_amdgcn_readfirstlane(__hip_atomic_load(cnt + 64 * u.pm, __ATOMIC_RELAXED, __HIP_MEMORY_SCOPE_AGENT)) < 32u) { __builtin_amdgcn_s_sleep(2); if (++spins > (1u << 22)) break; }
            __builtin_amdgcn_fence(__ATOMIC_ACQUIRE, "agent");
            if (lane == 0) flag[0] = 1u;
        }
        asm volatile("s_waitcnt vmcnt(0) lgkmcnt(0)\n\ts_barrier" ::: "memory");
        if (lane < 32) {
            const float* sl = xbuf + ((size_t)u.pm * 256 + prow) * 4;
            const float ss = (__hip_atomic_load(sl + 0, __ATOMIC_RELAXED, __HIP_MEMORY_SCOPE_AGENT) + __hip_atomic_load(sl + 1, __ATOMIC_RELAXED, __HIP_MEMORY_SCOPE_AGENT)) +
                             (__hip_atomic_load(sl + 2, __ATOMIC_RELAXED, __HIP_MEMORY_SCOPE_AGENT) + __hip_atomic_load(sl + 3, __ATOMIC_RELAXED, __HIP_MEMORY_SCOPE_AGENT));
            S[prow] = 1.0f / sqrtf(ss * (1.f / 1024.f) + 1e-6f);
        }
        asm volatile("s_waitcnt vmcnt(0) lgkmcnt(0)\n\ts_barrier" ::: "memory");
        pg8::f32x4 gv[2][2];
#pragma unroll
        for (int bj = 0; bj < 2; ++bj)
#pragma unroll
            for (int n = 0; n < 2; ++n) gv[bj][n] = *(const pg8::f32x4*)(gain + col0 + bj * 128 + n * 16);
#pragma unroll
        for (int ai = 0; ai < 2; ++ai)
#pragma unroll
            for (int m = 0; m < 4; ++m) {
                const float rr = S[ai * 128 + wr * 64 + m * 16 + fr_];
#pragma unroll
                for (int bj = 0; bj < 2; ++bj)
#pragma unroll
                    for (int n = 0; n < 2; ++n) *(pg8::f32x4*)(OUT + (size_t)(row0 + ai * 128 + m * 16) * 1024 + col0 + bj * 128 + n * 16) = acc[ai][bj][m][n] * rr * gv[bj][n];
            }
    }
};

struct Args { const float* in[9]; float* out; unsigned char* ws; int ph_lo, ph_hi; };
struct Frame {
    LAS unsigned char* lds;
    int tid, lane, wave, G;
    const float *x, *norm_gain, *w_in, *rel_bias, *gn_gain, *w_out_attn, *w_out_ret, *w_out, *final_gain;
    float* out; unsigned char* ws;
    __device__ __forceinline__ bf16* WinT() const { return (bf16*)(ws + WS_WIN); }
    __device__ __forceinline__ bf16* WcatT() const { return (bf16*)(ws + WS_WCAT); }
    __device__ __forceinline__ bf16* WoT() const { return (bf16*)(ws + WS_WO); }
    __device__ __forceinline__ bf16* H() const { return (bf16*)(ws + WS_H); }
    __device__ __forceinline__ bf16* ST() const { return (bf16*)(ws + WS_ST); }
    __device__ __forceinline__ bf16* QA() const { return (bf16*)((unsigned char*)out + 0 * MiB); }
    __device__ __forceinline__ bf16* KA() const { return (bf16*)((unsigned char*)out + 64 * MiB); }
    __device__ __forceinline__ bf16* VA() const { return (bf16*)((unsigned char*)out + 128 * MiB); }
    __device__ __forceinline__ bf16* GA() const { return (bf16*)((unsigned char*)out + 192 * MiB); }
    __device__ __forceinline__ bf16* QR() const { return (bf16*)(ws + WS_QR); }
    __device__ __forceinline__ bf16* KDR() const { return (bf16*)(ws + WS_KDR); }
    __device__ __forceinline__ bf16* VR() const { return (bf16*)(ws + WS_VR); }
    __device__ __forceinline__ bf16* GR() const { return (bf16*)(ws + WS_GR); }
    __device__ __forceinline__ bf16* SA() const { return (bf16*)((unsigned char*)out + 0 * MiB); }
    __device__ __forceinline__ bf16* SR() const { return (bf16*)((unsigned char*)out + 128 * MiB); }
    __device__ __forceinline__ bf16* ACAT() const { return (bf16*)(ws + WS_ACAT); }
    __device__ __forceinline__ bf16* MIXED() const { return (bf16*)(ws + WS_MIXED); }
    __device__ __forceinline__ float* TMP() const { return (float*)(ws + WS_TMP); }
};
__device__ __forceinline__ float wave_sum(float v) {
#pragma unroll
    for (int o = 1; o < 64; o <<= 1) v += __shfl_xor(v, o);
    return v;
}

__device__ __forceinline__ int win_src_col(int c) {
    if (c >= 2048 && c < 3072) { const int p = c & 63; return (c & ~63) + ((p >> 2) & 1) * 32 + 16 * (p >> 5) + 4 * ((p >> 3) & 3) + (p & 3); }
    if (c >= 5120) { const int cc = c - 5120; return 5120 + ((cc >> 7) & 1) * 1024 + (cc >> 8) * 128 + (cc & 127); }
    return c;
}
template <bool WIN> __device__ __forceinline__ void p0_transpose_item(const float* W, int K, int N, bf16* WT, int ldo, int col_off, LAS float* scr, int item, int lane) {
    const int nblk = N / 32, kb = item / nblk, nb = item % nblk, k0 = 64 * kb, n0 = 32 * nb;
    const int sc = WIN ? win_src_col(n0 + (lane & 31)) : (n0 + (lane & 31));
#pragma unroll 8
    for (int i = 0; i < 32; ++i) { const int kk = 2 * i + (lane >> 5); scr[kk * 33 + (lane & 31)] = W[(size_t)(k0 + kk) * N + sc]; }
    asm volatile("s_waitcnt lgkmcnt(0)" ::: "memory");
    const int c = lane & 7;
#pragma unroll
    for (int j = 0; j < 4; ++j) { const int n = (lane >> 3) + 8 * j; const LAS float* s = scr + (8 * c) * 33 + n;
        u32x4 o; o.x = pk2(s[0 * 33], s[1 * 33]); o.y = pk2(s[2 * 33], s[3 * 33]); o.z = pk2(s[4 * 33], s[5 * 33]); o.w = pk2(s[6 * 33], s[7 * 33]);
        *(u32x4*)(WT + (size_t)(n0 + n) * ldo + col_off + k0 + 8 * c) = o; }
    asm volatile("s_waitcnt lgkmcnt(0)" ::: "memory");
}
__device__ __forceinline__ void p0_prologue(Frame& F) {
    LAS float* scr = (LAS float*)(F.lds + F.wave * 16384);
    const int gw = blockIdx.x * 8 + F.wave, NGW = F.G * 8;
    constexpr int I_IN = (DM / 64) * (NIN / 32), I_A = (AW / 64) * (DM / 32), I_R = (RVW / 64) * (DM / 32), I_O = (DM / 64) * (DM / 32);
    for (int it = gw; it < I_IN + I_A + I_R + I_O; it += NGW) {
        int r = it;
        if (r < I_IN) { p0_transpose_item<true>(F.w_in, DM, NIN, F.WinT(), DM, 0, scr, r, F.lane); continue; } r -= I_IN;
        if (r < I_A) { p0_transpose_item<false>(F.w_out_attn, AW, DM, F.WcatT(), KCAT, 0, scr, r, F.lane); continue; } r -= I_A;
        if (r < I_R) { p0_transpose_item<false>(F.w_out_ret, RVW, DM, F.WcatT(), KCAT, AW, scr, r, F.lane); continue; } r -= I_R;
        p0_transpose_item<false>(F.w_out, DM, DM, F.WoT(), DM, 0, scr, r, F.lane);
    }
    for (int m = gw; m < T; m += NGW) {
        const f32x4* xr = (const f32x4*)(F.x + (size_t)m * DM) + F.lane;
        const f32x4* gr = (const f32x4*)F.norm_gain + F.lane;
        f32x4 v[4]; float s = 0.f;
#pragma unroll
        for (int j = 0; j < 4; ++j) { v[j] = xr[64 * j]; s += (v[j].x * v[j].x + v[j].y * v[j].y) + (v[j].z * v[j].z + v[j].w * v[j].w); }
        const float r = 1.0f / sqrtf(wave_sum(s) * (1.f / DM) + 1e-6f);
        unsigned long long* o8 = (unsigned long long*)(F.H() + (size_t)m * DM) + F.lane;
#pragma unroll
        for (int j = 0; j < 4; ++j) { const f32x4 g = gr[64 * j]; o8[64 * j] = (unsigned long long)pk2(v[j].x * r * g.x, v[j].y * r * g.y) | ((unsigned long long)pk2(v[j].z * r * g.z, v[j].w * r * g.w) << 32); }
    }
}

__device__ __forceinline__ void load_row64(const bf16* p, float (&q)[64]) {
#pragma unroll
    for (int i = 0; i < 8; ++i) { const u32x4 w = *(const u32x4*)(p + 8 * i);
        q[8 * i + 0] = bf2f(w.x & 0xffffu); q[8 * i + 1] = bf2f(w.x >> 16); q[8 * i + 2] = bf2f(w.y & 0xffffu); q[8 * i + 3] = bf2f(w.y >> 16);
        q[8 * i + 4] = bf2f(w.z & 0xffffu); q[8 * i + 5] = bf2f(w.z >> 16); q[8 * i + 6] = bf2f(w.w & 0xffffu); q[8 * i + 7] = bf2f(w.w >> 16); }
}
#define UNPK8(V_, e) const float e##0 = bf2f((V_)[0] & 0xffffu), e##1 = bf2f((V_)[0] >> 16), e##2 = bf2f((V_)[1] & 0xffffu), e##3 = bf2f((V_)[1] >> 16), e##4 = bf2f((V_)[2] & 0xffffu), e##5 = bf2f((V_)[2] >> 16), e##6 = bf2f((V_)[3] & 0xffffu), e##7 = bf2f((V_)[3] >> 16)
__device__ __forceinline__ float dot_row64(const float (&q)[64], const bf16* p) {
    float s = 0.f;
#pragma unroll
    for (int i = 0; i < 8; ++i) { const u32x4 w = *(const u32x4*)(p + 8 * i); UNPK8(w, k);
        s += q[8 * i] * k0 + q[8 * i + 1] * k1 + q[8 * i + 2] * k2 + q[8 * i + 3] * k3 + q[8 * i + 4] * k4 + q[8 * i + 5] * k5 + q[8 * i + 6] * k6 + q[8 * i + 7] * k7; }
    return s;
}
__device__ __forceinline__ void p2_attn_ref(Frame& F) {
    const int gw = blockIdx.x * 8 + F.wave, NGW = F.G * 8, lane = F.lane;
    for (int it = gw; it < BATCH * NCH * 8; it += NGW) {
        const int h = it & 7, n = (it >> 3) & (NCH - 1), b = it >> 10;
        const size_t t = (size_t)b * SEQ + n * 64 + lane;
        float q[64], o[64]; load_row64(F.QA() + t * AW + h * 64, q);
#pragma unroll
        for (int d = 0; d < 64; ++d) o[d] = 0.f;
        float mrun = -1e30f, l = 0.f;
        const int p0 = (n >= 8) ? 0 : (8 - n) * 64;
        const float* bias = F.rel_bias + h * 257;
        for (int p = p0; p < 576; ++p) {
            const size_t tk = (size_t)b * SEQ + (n - 8) * 64 + p;
            float s = dot_row64(q, F.KA() + tk * AW + h * 64);
            int dist = lane + 512 - p; dist = dist > 128 ? 128 : dist;
            s += bias[dist + 128] * LOG2E;
            const float mn = fmaxf(mrun, s), al = fast_exp2(mrun - mn), pp = fast_exp2(s - mn);
            mrun = mn; l = l * al + pp;
            const bf16* vp = F.VA() + tk * AW + h * 64;
#pragma unroll
            for (int i = 0; i < 8; ++i) { const u32x4 w = *(const u32x4*)(vp + 8 * i); UNPK8(w, v);
                o[8 * i] = o[8 * i] * al + pp * v0; o[8 * i + 1] = o[8 * i + 1] * al + pp * v1; o[8 * i + 2] = o[8 * i + 2] * al + pp * v2; o[8 * i + 3] = o[8 * i + 3] * al + pp * v3;
                o[8 * i + 4] = o[8 * i + 4] * al + pp * v4; o[8 * i + 5] = o[8 * i + 5] * al + pp * v5; o[8 * i + 6] = o[8 * i + 6] * al + pp * v6; o[8 * i + 7] = o[8 * i + 7] * al + pp * v7; }
        }
        const float rl = 1.0f / l;
        const bf16* gp = F.GA() + t * AW + h * 64;
        bf16* op = F.ACAT() + t * KCAT + h * 64;
#pragma unroll
        for (int i = 0; i < 8; ++i) { const u32x4 gw4 = *(const u32x4*)(gp + 8 * i); UNPK8(gw4, g);
            u32x4 w; w.x = pk2(o[8 * i] * rl * g0, o[8 * i + 1] * rl * g1); w.y = pk2(o[8 * i + 2] * rl * g2, o[8 * i + 3] * rl * g3);
            w.z = pk2(o[8 * i + 4] * rl * g4, o[8 * i + 5] * rl * g5); w.w = pk2(o[8 * i + 6] * rl * g6, o[8 * i + 7] * rl * g7); *(u32x4*)(op + 8 * i) = w; }
    }
}

typedef short bf16x8 __attribute__((ext_vector_type(8)));
typedef float f32x16 __attribute__((ext_vector_type(16)));
typedef short s16x4 __attribute__((ext_vector_type(4)));
typedef float f32x2_t __attribute__((ext_vector_type(2)));
typedef __bf16 bf16x2_t __attribute__((ext_vector_type(2)));
__device__ __forceinline__ unsigned cvtpk(float lo, float hi) { f32x2_t v = {lo, hi}; bf16x2_t b = __builtin_convertvector(v, bf16x2_t); return __builtin_bit_cast(unsigned, b); }
__device__ __forceinline__ s16x4 lds_tr16a(const LAS unsigned char* p) { s16x4 r; const unsigned a = (unsigned)(unsigned long long)p; asm volatile("ds_read_b64_tr_b16 %0, %1" : "=v"(r) : "v"(a) : "memory"); return r; }
__device__ __forceinline__ void dma16_asm(const void* g, unsigned lds_byte) { asm volatile("s_mov_b32 m0, %1\n\ts_nop 0\n\tglobal_load_lds_dwordx4 %0, off" :: "v"(g), "s"(lds_byte) : "memory"); }
template <int OFF> __device__ __forceinline__ s16x4 lds_tr16o(unsigned a) { s16x4 r; asm volatile("ds_read_b64_tr_b16 %0, %1 offset:%c2" : "=v"(r) : "v"(a), "i"(OFF) : "memory"); return r; }
__device__ __forceinline__ unsigned lds_off(const LAS unsigned char* p) { return (unsigned)(unsigned long long)p; }
#define TR_WAIT() do { asm volatile("s_waitcnt lgkmcnt(0)" ::: "memory"); __builtin_amdgcn_sched_barrier(0); } while (0)
__device__ __forceinline__ s16x4 lds_tr16(const LAS unsigned char* p) { return __builtin_bit_cast(s16x4, __builtin_amdgcn_ds_read_tr16_b64_v4i16((LAS s16x4*)p)); }
__device__ __forceinline__ bf16x8 pack8(const f32x16& p, int b) {
    u32x4 w; w.x = cvtpk(p[b], p[b + 1]); w.y = cvtpk(p[b + 2], p[b + 3]); w.z = cvtpk(p[b + 4], p[b + 5]); w.w = cvtpk(p[b + 6], p[b + 7]); return __builtin_bit_cast(bf16x8, w);
}
#define MFMA32(a, b, c) __builtin_amdgcn_mfma_f32_32x32x16_bf16((a), (b), (c), 0, 0, 0)
constexpr int ATT_TBL_OFF = 131072;
__device__ __forceinline__ void p5_attn_mfma(Frame& F) {
    LAS unsigned char* lds = F.lds;
    LAS float* tbl = (LAS float*)(lds + ATT_TBL_OFF);
    for (int i = (F.wave << 6) | lane_id_asm(); i < 8 * 257; i += 512) { const int hh = i / 257, k = i - hh * 257; tbl[hh * 260 + k] = F.rel_bias[i] * LOG2E; }
    __syncthreads();
    LAS unsigned char* wl = lds + F.wave * 16384;
    for (int gi = blockIdx.x; gi < BATCH * 8 * 16; gi += F.G) {
        const int g = (F.G == 256) ? ((gi & 7) * 32 + ((gi >> 3) & 31) + (gi & ~255)) : gi;
        const int h = (g >> 4) & 7, n = (g & 15) * 8 + F.wave, b = g >> 7;
        __builtin_amdgcn_s_barrier();
        const int lane = lane_id_asm(), r32 = lane & 31, hi = lane >> 5, l16 = lane & 15, g16 = (lane >> 4) & 1;
        const int kread = r32 * 128;
        const int vsw = ((l16 >> 3) & 1) << 2, vbase = (l16 >> 2) * 128 + 8 * (l16 & 1), vc = 2 * g16 + ((l16 & 3) >> 1);
        const int drow = lane >> 3, cpos = lane & 7;
        const int ksrc = drow * AW + ((cpos ^ drow) << 3);
        const int vsrc = drow * AW + ((cpos ^ (((drow >> 1) & 1) << 2)) << 3);
        const long tq0 = (long)b * SEQ + n * 64, tk0 = tq0 - 512;
        const LAS float* tblh = tbl + h * 260;
        const float cb = tblh[256];
        bf16x8 qf[2][4];
#pragma unroll
        for (int qb = 0; qb < 2; ++qb)
#pragma unroll
            for (int s = 0; s < 4; ++s) qf[qb][s] = *(const bf16x8*)(F.QA() + (tq0 + 32 * qb + r32) * AW + h * 64 + 16 * s + 8 * hi);
        f32x16 ot[2][2];
#pragma unroll
        for (int a = 0; a < 2; ++a)
#pragma unroll
            for (int c = 0; c < 2; ++c)
#pragma unroll
                for (int r = 0; r < 16; ++r) ot[a][c][r] = 0.f;
        float mrun[2] = {-1e30f, -1e30f}, lsum[2] = {0.f, 0.f};
        const int jt0 = (n >= 8) ? 0 : 2 * (8 - n);
        const bf16* kg = F.KA() + tk0 * AW + h * 64; const bf16* vg = F.VA() + tk0 * AW + h * 64;
#define ATT_ISSUE_K(jt_, sl_) do { LAS unsigned char* d_ = wl + (sl_) * 8192; const long ro_ = (long)(jt_) * 32 * AW; \
        _Pragma("unroll") for (int ii = 0; ii < 4; ++ii) __builtin_amdgcn_global_load_lds((const unsigned*)(kg + ro_ + ii * 8 * AW + ksrc), (LAS unsigned*)(d_ + ii * 1024), 16, 0, 0); } while (0)
#define ATT_ISSUE_V(jt_, sl_) do { LAS unsigned char* d_ = wl + (sl_) * 8192 + 4096; const long ro_ = (long)(jt_) * 32 * AW; \
        _Pragma("unroll") for (int ii = 0; ii < 4; ++ii) __builtin_amdgcn_global_load_lds((const unsigned*)(vg + ro_ + ii * 8 * AW + vsrc), (LAS unsigned*)(d_ + ii * 1024), 16, 0, 0); } while (0)
#define ATT_STEP(X, Y, JT, KS, VSP, HAVE_QK, HAVE_PREV) do { \
        bf16x8 kf[4]; s16x4 vlo[2][2], vhi[2][2]; float psn[2] = {0.f, 0.f}, al[2] = {1.f, 1.f}, mo[2] = {0.f, 0.f}; u32x4 ppw[2][2]; \
        if (HAVE_QK) { const LAS unsigned char* ks_ = wl + (KS) * 8192; \
            _Pragma("unroll") for (int s = 0; s < 4; ++s) kf[s] = *(const LAS bf16x8*)(ks_ + kread + (((2 * s + hi) ^ (r32 & 7)) << 4)); \
            _Pragma("unroll") for (int r = 0; r < 16; ++r) { X[0][r] = 0.f; X[1][r] = 0.f; } } \
        if (HAVE_PREV) { _Pragma("unroll") for (int db = 0; db < 2; ++db) { const unsigned vb_ = lds_off(wl + (VSP) * 8192 + 4096) + 4 * hi * 128 + vbase + (((4 * db + vc) ^ vsw) << 4); \
            vlo[db][0] = lds_tr16o<0>(vb_); vhi[db][0] = lds_tr16o<1024>(vb_); vlo[db][1] = lds_tr16o<2048>(vb_); vhi[db][1] = lds_tr16o<3072>(vb_); } } \
        __builtin_amdgcn_sched_barrier(0); \
        _Pragma("unroll") for (int k = 0; k < 8; ++k) {                                      \
            if (HAVE_QK) { const int s = k >> 1, qb = k & 1; X[qb] = MFMA32(kf[s], qf[qb][s], X[qb]); } \
            if (HAVE_PREV) { const int q = k >> 2, j = k & 3; \
                float t_ = (Y[q][4 * j] + Y[q][4 * j + 1]) + (Y[q][4 * j + 2] + Y[q][4 * j + 3]); psn[q] += t_; \
                unsigned w0 = cvtpk(Y[q][4 * j], Y[q][4 * j + 1]), w1 = cvtpk(Y[q][4 * j + 2], Y[q][4 * j + 3]); \
                asm volatile("" : "+v"(psn[q]), "+v"(w0), "+v"(w1)); \
                ppw[q][j >> 1][2 * (j & 1)] = w0; ppw[q][j >> 1][2 * (j & 1) + 1] = w1; } \
            __builtin_amdgcn_sched_barrier(0); } \
        if (HAVE_QK) {                                                                         \
            float bc = cb; \
            if ((JT) >= 12) { bc = 0.f; \
                _Pragma("unroll") for (int qb = 0; qb < 2; ++qb) { _Pragma("unroll") for (int r = 0; r < 16; ++r) { int dist = 32 * qb + r32 + 512 - 32 * (JT) - ((r & 3) + 8 * (r >> 2) + 4 * hi); dist = dist > 128 ? 128 : dist; X[qb][r] += tblh[dist + 128]; } } } \
            _Pragma("unroll") for (int qb = 0; qb < 2; ++qb) { \
                float mx = X[qb][0]; \
                _Pragma("unroll") for (int r = 1; r < 16; ++r) mx = fmaxf(mx, X[qb][r]); \
                mx = fmaxf(mx, __shfl_xor(mx, 32)) + bc; \
                const float mn = fmaxf(mrun[qb], mx); al[qb] = fast_exp2(mrun[qb] - mn); mrun[qb] = mn; mo[qb] = mn - bc; \
                lsum[qb] = (lsum[qb] + psn[qb]) * al[qb]; } \
        } else { lsum[0] += psn[0]; lsum[1] += psn[1]; } \
        if (HAVE_PREV) TR_WAIT(); else __builtin_amdgcn_sched_barrier(0); \
        _Pragma("unroll") for (int k = 0; k < 8; ++k) {                                      \
            if (HAVE_PREV) { const int db = k >> 2, s2 = (k >> 1) & 1, qb = k & 1; \
                const bf16x8 vf = {vlo[db][s2][0], vlo[db][s2][1], vlo[db][s2][2], vlo[db][s2][3], vhi[db][s2][0], vhi[db][s2][1], vhi[db][s2][2], vhi[db][s2][3]}; \
                ot[db][qb] = MFMA32(vf, __builtin_bit_cast(bf16x8, ppw[qb][s2]), ot[db][qb]); } \
            if (HAVE_QK) { const int q = k >> 2, j = k & 3; \
                _Pragma("unroll") for (int e = 0; e < 4; ++e) X[q][4 * j + e] = fast_exp2(X[q][4 * j + e] - mo[q]); \
                asm volatile("" : "+v"(X[q][4 * j]), "+v"(X[q][4 * j + 1]), "+v"(X[q][4 * j + 2]), "+v"(X[q][4 * j + 3])); } \
            __builtin_amdgcn_sched_barrier(0); } \
        if (HAVE_QK) { _Pragma("unroll") for (int qb = 0; qb < 2; ++qb) _Pragma("unroll") for (int r = 0; r < 16; ++r) { ot[0][qb][r] *= al[qb]; ot[1][qb][r] *= al[qb]; } } \
        __builtin_amdgcn_sched_barrier(0); } while (0)
#define ATT_NX(j_) (((j_) + 1 == 18) ? jt0 : (j_) + 1)
        const int ntl = 18 - jt0;
        int jc = (n >= 8) ? 2 * ((143 - n) % 9) : jt0;
        f32x16 saA[2], saB[2];
        ATT_ISSUE_K(jc, 0);
        { const int jn = ATT_NX(jc); ATT_ISSUE_K(jn, 1); ATT_ISSUE_V(jc, 0); asm volatile("s_waitcnt vmcnt(8)" ::: "memory");
          ATT_STEP(saA, saB, jc, 0, 0, 1, 0); jc = jn; }
        for (int t = 1; t + 2 < ntl; t += 2) {
            { const int jn = ATT_NX(jc); ATT_ISSUE_K(jn, 0); ATT_ISSUE_V(jc, 1); asm volatile("s_waitcnt vmcnt(8)" ::: "memory");
              ATT_STEP(saB, saA, jc, 1, 0, 1, 1); jc = jn; }
            { const int jn = ATT_NX(jc); ATT_ISSUE_K(jn, 1); ATT_ISSUE_V(jc, 0); asm volatile("s_waitcnt vmcnt(8)" ::: "memory");
              ATT_STEP(saA, saB, jc, 0, 1, 1, 1); jc = jn; }
        }
        { ATT_ISSUE_V(jc, 1); asm volatile("s_waitcnt vmcnt(4)" ::: "memory");
          ATT_STEP(saB, saA, jc, 1, 0, 1, 1); }
        { asm volatile("s_waitcnt vmcnt(0)" ::: "memory");
          ATT_STEP(saA, saB, 0, 0, 1, 0, 1); }
#undef ATT_STEP
#undef ATT_ISSUE_K
#undef ATT_ISSUE_V
#undef ATT_NX
#pragma unroll
        for (int qb = 0; qb < 2; ++qb) {
            const float lt = lsum[qb] + __shfl_xor(lsum[qb], 32), inv = 1.0f / lt;
            const long t = tq0 + 32 * qb + r32;
#pragma unroll
            for (int db = 0; db < 2; ++db)
#pragma unroll
                for (int gp = 0; gp < 2; ++gp) {
                    const int d0 = 32 * db + 16 * gp + 8 * hi;
                    const u32x4 q4 = *(const u32x4*)(F.GA() + t * AW + h * 64 + d0);
                    const auto a0 = __builtin_amdgcn_permlane32_swap(q4.x, q4.z, false, false), a1 = __builtin_amdgcn_permlane32_swap(q4.y, q4.w, false, false);
                    u32x2 w[2];
#pragma unroll
                    for (int e = 0; e < 2; ++e) { const int g = 2 * gp + e; const unsigned gx = a0[e], gy = a1[e];
                        w[e].x = cvtpk(ot[db][qb][4 * g] * inv * bf2f(gx & 0xffffu), ot[db][qb][4 * g + 1] * inv * bf2f(gx >> 16));
                        w[e].y = cvtpk(ot[db][qb][4 * g + 2] * inv * bf2f(gy & 0xffffu), ot[db][qb][4 * g + 3] * inv * bf2f(gy >> 16)); }
                    const auto s0 = __builtin_amdgcn_permlane32_swap(w[0].x, w[1].x, false, false), s1 = __builtin_amdgcn_permlane32_swap(w[0].y, w[1].y, false, false);
                    const u32x4 w4 = {s0[0], s1[0], s0[1], s1[1]};
                    *(u32x4*)(F.ACAT() + t * KCAT + h * 64 + d0) = w4;
                }
        }
    }
}


constexpr int SC_S0_OFF = 131072;
__device__ __forceinline__ void p2_scan_mfma(Frame& F) {
    const int lane = F.lane, r32 = lane & 31, hi = lane >> 5, l16 = lane & 15, g16 = (lane >> 4) & 1, w = F.wave;
    LAS unsigned char* reg = F.lds + w * 16384;
    const int xq = l16 >> 2, x1 = (l16 & 3) >> 1, x0 = l16 & 1;
    const int ka_off = (8 * hi + xq) * 128 + 8 * x0, ka_sw = ((l16 >> 3) & 1) << 2, ka_c = 2 * g16 + x1;
    const int vb_off = (8 * hi + xq) * 64 + ((2 * g16 + x1) << 4) + 8 * x0;
    const int kdrow = lane >> 3, kc16 = (lane & 7) ^ ((((lane >> 3) >> 1) & 1) << 2);
    const int vdrow = lane >> 2, vc16 = lane & 3;
    for (int unit = blockIdx.x; unit < BATCH * 8 * 4; unit += F.G) {
        const int i = unit & 3, h = (unit >> 2) & 7, b = unit >> 5;
        const float g64 = fast_exp2(64.0f * log2gamma(h));
        const bf16* kg = F.KDR() + ((long)b * SEQ + kdrow) * RQK + h * 64 + kc16 * 8;
        const bf16* vg = F.VR() + ((long)b * SEQ + vdrow) * RVW + h * 128 + 32 * i + vc16 * 8;
        bf16* stg = F.ST() + (long)(b * 8 + h) * NCH * 8192 + i * 2048 + lane * 8;
#define SC_ISSUE(n_) do { const long ro_ = (long)(n_) * 64; \
        _Pragma("unroll") for (int ii = 0; ii < 8; ++ii) __builtin_amdgcn_global_load_lds((const unsigned*)(kg + (ro_ + 8 * ii) * RQK), (LAS unsigned*)(reg + ii * 1024), 16, 0, 0); \
        _Pragma("unroll") for (int ii = 0; ii < 4; ++ii) __builtin_amdgcn_global_load_lds((const unsigned*)(vg + (ro_ + 16 * ii) * RVW), (LAS unsigned*)(reg + 8192 + ii * 1024), 16, 0, 0); } while (0)
        { LAS f32x4* z = (LAS f32x4*)(F.lds + SC_S0_OFF); for (int k = F.tid; k < 512; k += 512) z[k] = (f32x4){0.f, 0.f, 0.f, 0.f}; }
        SC_ISSUE(w);
        for (int r = 0; r < 12; ++r) {
            const int n = 8 * r + w;
            asm volatile("s_waitcnt vmcnt(0)" ::: "memory");
            s16x4 bl[4], bh[4], al[2][4], ah[2][4];
            { const unsigned vb_ = lds_off(reg) + 8192 + vb_off;
              bl[0] = lds_tr16o<0>(vb_); bh[0] = lds_tr16o<256>(vb_); bl[1] = lds_tr16o<1024>(vb_); bh[1] = lds_tr16o<1280>(vb_);
              bl[2] = lds_tr16o<2048>(vb_); bh[2] = lds_tr16o<2304>(vb_); bl[3] = lds_tr16o<3072>(vb_); bh[3] = lds_tr16o<3328>(vb_); }
#pragma unroll
            for (int jb = 0; jb < 2; ++jb) { const unsigned kb_ = lds_off(reg) + ka_off + (((4 * jb + ka_c) ^ ka_sw) << 4);
              al[jb][0] = lds_tr16o<0>(kb_); ah[jb][0] = lds_tr16o<512>(kb_); al[jb][1] = lds_tr16o<2048>(kb_); ah[jb][1] = lds_tr16o<2560>(kb_);
              al[jb][2] = lds_tr16o<4096>(kb_); ah[jb][2] = lds_tr16o<4608>(kb_); al[jb][3] = lds_tr16o<6144>(kb_); ah[jb][3] = lds_tr16o<6656>(kb_); }
            TR_WAIT();
            if (r < 11) SC_ISSUE(n + 8);
            f32x16 kv[2];
#pragma unroll
            for (int rr = 0; rr < 16; ++rr) { kv[0][rr] = 0.f; kv[1][rr] = 0.f; }
#pragma unroll
            for (int s = 0; s < 4; ++s) {
                const bf16x8 bfr = {bl[s][0], bl[s][1], bl[s][2], bl[s][3], bh[s][0], bh[s][1], bh[s][2], bh[s][3]};
#pragma unroll
                for (int jb = 0; jb < 2; ++jb) {
                    const bf16x8 afr = {al[jb][s][0], al[jb][s][1], al[jb][s][2], al[jb][s][3], ah[jb][s][0], ah[jb][s][1], ah[jb][s][2], ah[jb][s][3]};
                    kv[jb] = MFMA32(afr, bfr, kv[jb]);
                }
            }
            { LAS u32x4* kq = (LAS u32x4*)(reg + 12288 + 64 * lane);
#pragma unroll
              for (int jb = 0; jb < 2; ++jb) { kq[2 * jb] = __builtin_bit_cast(u32x4, pack8(kv[jb], 0)); kq[2 * jb + 1] = __builtin_bit_cast(u32x4, pack8(kv[jb], 8)); } }
            asm volatile("s_waitcnt lgkmcnt(0)\n\ts_barrier" ::: "memory");
            f32x16 S[2];
            { const LAS f32x4* s0 = (const LAS f32x4*)(F.lds + SC_S0_OFF + (r & 1) * 8192 + 128 * lane);
#pragma unroll
              for (int jb = 0; jb < 2; ++jb)
#pragma unroll
                  for (int q4 = 0; q4 < 4; ++q4) { const f32x4 v = s0[4 * jb + q4]; S[jb][4 * q4] = v[0]; S[jb][4 * q4 + 1] = v[1]; S[jb][4 * q4 + 2] = v[2]; S[jb][4 * q4 + 3] = v[3]; } }
            for (int j = 0; j < w; ++j) {
                const LAS u32x4* kq = (const LAS u32x4*)(F.lds + j * 16384 + 12288 + 64 * lane);
#pragma unroll
                for (int jb = 0; jb < 2; ++jb)
#pragma unroll
                    for (int hq = 0; hq < 2; ++hq) { const u32x4 v = kq[2 * jb + hq];
                        S[jb][8 * hq + 0] = S[jb][8 * hq + 0] * g64 + bf2f(v.x & 0xffffu); S[jb][8 * hq + 1] = S[jb][8 * hq + 1] * g64 + bf2f(v.x >> 16);
                        S[jb][8 * hq + 2] = S[jb][8 * hq + 2] * g64 + bf2f(v.y & 0xffffu); S[jb][8 * hq + 3] = S[jb][8 * hq + 3] * g64 + bf2f(v.y >> 16);
                        S[jb][8 * hq + 4] = S[jb][8 * hq + 4] * g64 + bf2f(v.z & 0xffffu); S[jb][8 * hq + 5] = S[jb][8 * hq + 5] * g64 + bf2f(v.z >> 16);
                        S[jb][8 * hq + 6] = S[jb][8 * hq + 6] * g64 + bf2f(v.w & 0xffffu); S[jb][8 * hq + 7] = S[jb][8 * hq + 7] * g64 + bf2f(v.w >> 16); }
            }
#define SC_STORE(S_, n_) do { _Pragma("unroll") for (int jb = 0; jb < 2; ++jb) _Pragma("unroll") for (int gp = 0; gp < 2; ++gp) {     \
                    u32x2 wv[2]; \
                    _Pragma("unroll") for (int e = 0; e < 2; ++e) { const int g = 2 * gp + e; wv[e].x = cvtpk(S_[jb][4 * g], S_[jb][4 * g + 1]); wv[e].y = cvtpk(S_[jb][4 * g + 2], S_[jb][4 * g + 3]); } \
                    const auto s0 = __builtin_amdgcn_permlane32_swap(wv[0].x, wv[1].x, false, false), s1 = __builtin_amdgcn_permlane32_swap(wv[0].y, wv[1].y, false, false); \
                    const u32x4 w4 = {s0[0], s1[0], s0[1], s1[1]}; \
                    *(u32x4*)(stg + (long)(n_) * 8192 + (2 * jb + gp) * 512) = w4; } } while (0)
            if (w == 0 && (r == 4 || r == 8)) SC_STORE(S, n);
            if (w == 7) {
                LAS f32x4* s1 = (LAS f32x4*)(F.lds + SC_S0_OFF + ((r + 1) & 1) * 8192 + 128 * lane);
#pragma unroll
                for (int jb = 0; jb < 2; ++jb)
#pragma unroll
                    for (int q4 = 0; q4 < 4; ++q4) s1[4 * jb + q4] = (f32x4){S[jb][4 * q4] * g64 + kv[jb][4 * q4], S[jb][4 * q4 + 1] * g64 + kv[jb][4 * q4 + 1], S[jb][4 * q4 + 2] * g64 + kv[jb][4 * q4 + 2], S[jb][4 * q4 + 3] * g64 + kv[jb][4 * q4 + 3]};
            }
            asm volatile("s_waitcnt lgkmcnt(0)\n\ts_barrier" ::: "memory");
        }
        if (w == 0) {
            f32x16 S[2];
            const LAS f32x4* s0 = (const LAS f32x4*)(F.lds + SC_S0_OFF + 128 * lane);
#pragma unroll
            for (int jb = 0; jb < 2; ++jb)
#pragma unroll
                for (int q4 = 0; q4 < 4; ++q4) { const f32x4 v = s0[4 * jb + q4]; S[jb][4 * q4] = v[0]; S[jb][4 * q4 + 1] = v[1]; S[jb][4 * q4 + 2] = v[2]; S[jb][4 * q4 + 3] = v[3]; }
            SC_STORE(S, 96);
        }
        __syncthreads();
#undef SC_STORE
#undef SC_ISSUE
    }
}
__device__ __forceinline__ void p3_ret_mfma(Frame& F) {
    LAS unsigned char* vt = F.lds + F.wave * 16384;
    const int gw = blockIdx.x * 8 + F.wave, NGW = F.G * 8;
    for (int it = gw; it < BATCH * NCH * 8; it += NGW) {
        const int ln_ = lane_id_asm(); int r32 = ln_ & 31, hi = ln_ >> 5;
        const int l16 = ln_ & 15, g16 = (ln_ >> 4) & 1;
        const int vrd = (l16 >> 2) * 256 + 8 * (l16 & 1), vrsw = (l16 >> 2) << 2, vrc = 2 * g16 + ((l16 & 3) >> 1);
        const int ddrow = ln_ >> 4, dc16 = (ln_ & 15) ^ (((ln_ >> 4) & 3) << 2);
        const int h = it & 7, n = (it >> 3) & (NCH - 1), b = it >> 10;
        const long t0 = (long)b * SEQ + n * 64;
        const float l2g = log2gamma(h);
        { const bf16* vgs = F.VR() + t0 * RVW + h * 128; const unsigned vgo = (unsigned)(ddrow * RVW + dc16 * 8);
#pragma unroll
          for (int ii = 0; ii < 16; ++ii) __builtin_amdgcn_global_load_lds((const unsigned*)(vgs + ii * 4 * RVW + vgo), (LAS unsigned*)(vt + ii * 1024), 16, 0, 0); }
        int r32v = r32, hiv = hi; asm volatile("" : "+v"(r32v), "+v"(hiv));
        asm volatile("s_waitcnt vmcnt(0)" ::: "memory");
#pragma unroll 1
        for (int qb = 0; qb < 2; ++qb) {
            const bf16* stp = F.ST() + ((long)(b * 8 + h) * NCH + n) * 8192; const unsigned sto = (unsigned)((hiv * 32 + r32v) * 8);
            const long tq = t0 + 32 * qb; const unsigned rq = (unsigned)(r32 * RQK + 8 * hi), rv2 = (unsigned)(r32 * RVW + 8 * hi), ra2 = (unsigned)(r32 * KCAT + 8 * hi);
            bf16x8 qf[4], pp[4];
#pragma unroll
            for (int s = 0; s < 4; ++s) qf[s] = *(const bf16x8*)(F.QR() + tq * RQK + h * 64 + 16 * s + rq);
#pragma unroll
            for (int kb = 0; kb < 2; ++kb) {
                bf16x8 kf[4];
#pragma unroll
                for (int s = 0; s < 4; ++s) kf[s] = *(const bf16x8*)(F.KDR() + (t0 + 32 * kb) * RQK + h * 64 + 16 * s + rq);
                f32x16 sa;
#pragma unroll
                for (int r = 0; r < 16; ++r) sa[r] = 0.f;
#pragma unroll
                for (int s = 0; s < 4; ++s) sa = MFMA32(kf[s], qf[s], sa);
                __builtin_amdgcn_sched_barrier(0);
#pragma unroll
                for (int r = 0; r < 16; ++r) { const int k = 32 * kb + (r & 3) + 8 * (r >> 2) + 4 * hiv, q = 32 * qb + r32v; const int ad = q > k ? q - k : k - q;
                    sa[r] *= fast_exp2(l2g * (float)(ad - 63 + k)); }
                pp[2 * kb] = pack8(sa, 0); pp[2 * kb + 1] = pack8(sa, 8);
                __builtin_amdgcn_sched_barrier(0);
            }
            const float cr = fast_exp2(l2g * (float)(32 * qb + r32 + 1));
            f32x16 o[4];
#pragma unroll
            for (int db = 0; db < 4; ++db) {
                bf16x8 sf[4];
#pragma unroll
                for (int s = 0; s < 4; ++s) sf[s] = *(const bf16x8*)(stp + (db * 4 + s) * 512 + sto);
                s16x4 vlo[4], vhi[4];
                { const unsigned vb_ = lds_off(vt) + 4 * hi * 256 + vrd + (((4 * db + vrc) ^ vrsw) << 4);
                  vlo[0] = lds_tr16o<0>(vb_); vhi[0] = lds_tr16o<2048>(vb_); vlo[1] = lds_tr16o<4096>(vb_); vhi[1] = lds_tr16o<6144>(vb_);
                  vlo[2] = lds_tr16o<8192>(vb_); vhi[2] = lds_tr16o<10240>(vb_); vlo[3] = lds_tr16o<12288>(vb_); vhi[3] = lds_tr16o<14336>(vb_); }
#pragma unroll
                for (int r = 0; r < 16; ++r) o[db][r] = 0.f;
                TR_WAIT();
#pragma unroll
                for (int s4 = 0; s4 < 4; ++s4) {
                    const bf16x8 vf = {vlo[s4][0], vlo[s4][1], vlo[s4][2], vlo[s4][3], vhi[s4][0], vhi[s4][1], vhi[s4][2], vhi[s4][3]};
                    o[db] = MFMA32(vf, pp[s4], o[db]);
                }
                f32x16 oc;
#pragma unroll
                for (int r = 0; r < 16; ++r) oc[r] = 0.f;
#pragma unroll
                for (int s = 0; s < 4; ++s) oc = MFMA32(sf[s], qf[s], oc);
#pragma unroll
                for (int r = 0; r < 16; ++r) o[db][r] += cr * oc[r];
                __builtin_amdgcn_sched_barrier(0);
            }
            u32x2 gv[4][4];
#pragma unroll
            for (int db = 0; db < 4; ++db)
#pragma unroll
                for (int gp = 0; gp < 2; ++gp) {
                    const u32x4 q4 = *(const u32x4*)(F.GR() + tq * RVW + h * 128 + 32 * db + 16 * gp + rv2);
                    const auto s0 = __builtin_amdgcn_permlane32_swap(q4.x, q4.z, false, false), s1 = __builtin_amdgcn_permlane32_swap(q4.y, q4.w, false, false);
                    gv[db][2 * gp].x = s0[0]; gv[db][2 * gp].y = s1[0]; gv[db][2 * gp + 1].x = s0[1]; gv[db][2 * gp + 1].y = s1[1];
                }
            float sum = 0.f;
#pragma unroll
            for (int db = 0; db < 4; ++db)
#pragma unroll
                for (int r = 0; r < 16; ++r) sum += o[db][r];
            sum += __shfl_xor(sum, 32);
            const float mean = sum * (1.f / 128.f);
            float sq = 0.f;
#pragma unroll
            for (int db = 0; db < 4; ++db)
#pragma unroll
                for (int r = 0; r < 16; ++r) { const float d = o[db][r] - mean; sq += d * d; }
            sq += __shfl_xor(sq, 32);
            const float rstd = 1.0f / sqrtf(sq * (1.f / 128.f) + 1e-5f);
#pragma unroll
            for (int db = 0; db < 4; ++db)
#pragma unroll
                for (int gp = 0; gp < 2; ++gp) {
                    u32x2 w[2];
#pragma unroll
                    for (int e = 0; e < 2; ++e) { const int g = 2 * gp + e; const u32x2 q2 = gv[db][g];
                        w[e].x = cvtpk((o[db][4 * g] - mean) * rstd * bf2f(q2.x & 0xffffu), (o[db][4 * g + 1] - mean) * rstd * bf2f(q2.x >> 16));
                        w[e].y = cvtpk((o[db][4 * g + 2] - mean) * rstd * bf2f(q2.y & 0xffffu), (o[db][4 * g + 3] - mean) * rstd * bf2f(q2.y >> 16)); }
                    const auto s0 = __builtin_amdgcn_permlane32_swap(w[0].x, w[1].x, false, false), s1 = __builtin_amdgcn_permlane32_swap(w[0].y, w[1].y, false, false);
                    const u32x4 w4 = {s0[0], s1[0], s0[1], s1[1]};
                    *(u32x4*)(F.ACAT() + tq * KCAT + AW + h * 128 + 32 * db + 16 * gp + ra2) = w4;
                }
        }
    }
}

constexpr int R1_BUF = 49152;
__device__ __forceinline__ void p2_seg_state(Frame& F) {
    LAS unsigned char* lds = F.lds;
    const int w = F.wave, db = w & 3, th = w >> 2;
    const unsigned lds_base = (unsigned)__builtin_amdgcn_readfirstlane((int)lds_off(lds));
    for (int u0 = blockIdx.x; u0 < BATCH * 8 * 4; u0 += F.G) {
        const int u = (F.G == 256) ? ((u0 & 7) * 32 + (u0 >> 3)) : u0;
        const int seg = u & 3, h = (u >> 2) & 7, b = u >> 5, n0 = seg * 32;
        if (seg == 3) continue;
        const int ln = lane_id_asm(), hi = ln >> 5, l16 = ln & 15, g16 = (ln >> 4) & 1;
        const float l2g = log2gamma(h), g128 = fast_exp2(128.0f * l2g);
        const int drow = ln >> 3;
        const unsigned kt_src = (unsigned)(drow * RQK + (((ln & 7) ^ (((drow >> 1) & 1) << 2)) << 3));
        const unsigned v_src = (unsigned)((ln >> 4) * RVW + (((ln & 15) ^ (((ln >> 4) & 3) << 2)) << 3));
        const long tb = (long)b * SEQ + n0 * 64;
        const bf16* kg = F.KDR() + tb * RQK + h * 64; const bf16* vg = F.VR() + tb * RVW + h * 128;
#define R1_ISSUE(j_) do { _Pragma("unroll") for (int c_ = 0; c_ < 2; ++c_) { const unsigned bo_ = lds_base + ((j_) & 1) * R1_BUF + c_ * 24576 + w * 1024; const long ro_ = (long)(2 * (j_) + c_) * 64; \
        dma16_asm(kg + (ro_ + 8 * w) * RQK + kt_src, bo_); dma16_asm(vg + (ro_ + 4 * w) * RVW + v_src, bo_ + 8192); dma16_asm(vg + (ro_ + 32 + 4 * w) * RVW + v_src, bo_ + 8192 + 8192); } } while (0)
        R1_ISSUE(0);
        f32x16 acc[2];
#pragma unroll
        for (int r = 0; r < 16; ++r) { acc[0][r] = 0.f; acc[1][r] = 0.f; }
        const int xq = l16 >> 2, x1 = (l16 & 3) >> 1, x0 = l16 & 1;
        const unsigned ka_off = (unsigned)((4 * hi + xq) * 128 + 8 * x0), ka_sw = (unsigned)(((l16 >> 3) & 1) << 2), ka_c = (unsigned)(2 * g16 + x1);
        const unsigned vrd = (unsigned)((l16 >> 2) * 256 + 8 * (l16 & 1)), vrsw = (unsigned)((l16 >> 2) << 2), vrc = (unsigned)(2 * g16 + ((l16 & 3) >> 1));
#pragma unroll 1
        for (int j = 0; j < 16; ++j) {
            asm volatile("s_waitcnt vmcnt(0)\n\ts_barrier" ::: "memory");
            if (j + 1 < 16) R1_ISSUE(j + 1);
            LAS unsigned char* bufp = lds + (j & 1) * R1_BUF + th * 24576;
            s16x4 vlo[4], vhi[4], al[2][4], ah[2][4];
            { const unsigned vb_ = lds_off(bufp) + 8192 + 4 * hi * 256 + vrd + (((4 * db + vrc) ^ vrsw) << 4);
              vlo[0] = lds_tr16o<0>(vb_); vhi[0] = lds_tr16o<2048>(vb_); vlo[1] = lds_tr16o<4096>(vb_); vhi[1] = lds_tr16o<6144>(vb_);
              vlo[2] = lds_tr16o<8192>(vb_); vhi[2] = lds_tr16o<10240>(vb_); vlo[3] = lds_tr16o<12288>(vb_); vhi[3] = lds_tr16o<14336>(vb_); }
#pragma unroll
            for (int jb = 0; jb < 2; ++jb) { const unsigned kb_ = lds_off(bufp) + ka_off + (((4 * jb + ka_c) ^ ka_sw) << 4);
              al[jb][0] = lds_tr16o<0>(kb_); ah[jb][0] = lds_tr16o<1024>(kb_); al[jb][1] = lds_tr16o<2048>(kb_); ah[jb][1] = lds_tr16o<3072>(kb_);
              al[jb][2] = lds_tr16o<4096>(kb_); ah[jb][2] = lds_tr16o<5120>(kb_); al[jb][3] = lds_tr16o<6144>(kb_); ah[jb][3] = lds_tr16o<7168>(kb_); }
#pragma unroll
            for (int r = 0; r < 16; ++r) { acc[0][r] *= g128; acc[1][r] *= g128; }
            TR_WAIT();
#pragma unroll
            for (int s4 = 0; s4 < 4; ++s4) {
                const bf16x8 vf = {vlo[s4][0], vlo[s4][1], vlo[s4][2], vlo[s4][3], vhi[s4][0], vhi[s4][1], vhi[s4][2], vhi[s4][3]};
#pragma unroll
                for (int jb = 0; jb < 2; ++jb) {
                    const bf16x8 afr = {al[jb][s4][0], al[jb][s4][1], al[jb][s4][2], al[jb][s4][3], ah[jb][s4][0], ah[jb][s4][1], ah[jb][s4][2], ah[jb][s4][3]};
                    acc[jb] = MFMA32(afr, vf, acc[jb]);
                }
            }
        }
#undef R1_ISSUE
        { f32x4* eg = (f32x4*)F.ST() + ((long)((u * 2 + th) * 4 + db) * 8) * 64 + ln;
#pragma unroll
          for (int jb = 0; jb < 2; ++jb)
#pragma unroll
              for (int q4 = 0; q4 < 4; ++q4) eg[(4 * jb + q4) * 64] = (f32x4){acc[jb][4 * q4], acc[jb][4 * q4 + 1], acc[jb][4 * q4 + 2], acc[jb][4 * q4 + 3]}; }
        __syncthreads();
    }
}
constexpr int R2_BUF = 40960;
constexpr int R2_STAT = 2 * R2_BUF;
__device__ __forceinline__ void p3_ret2(Frame& F) {
    LAS unsigned char* lds = F.lds;
    const int w = F.wave, db = w & 3, th = w >> 2;
    const unsigned lds_base = (unsigned)__builtin_amdgcn_readfirstlane((int)lds_off(lds));
    for (int u0 = blockIdx.x; u0 < BATCH * 8 * 4; u0 += F.G) {
        const int u = (F.G == 256) ? ((u0 & 7) * 32 + (u0 >> 3)) : u0;
        const int ln = lane_id_asm(), r32 = ln & 31, hi = ln >> 5, l16 = ln & 15, g16 = (ln >> 4) & 1;
        const int seg = u & 3, h = (u >> 2) & 7, b = u >> 5, n0 = seg * 32;
        const float l2g = log2gamma(h), g64 = fast_exp2(64.0f * l2g);
        const int drow = ln >> 3;
        const unsigned qk_src = (unsigned)(drow * RQK + (((ln & 7) ^ drow) << 3));
        const unsigned kt_src = (unsigned)(drow * RQK + (((ln & 7) ^ (((drow >> 1) & 1) << 2)) << 3));
        const unsigned v_src = (unsigned)((ln >> 4) * RVW + (((ln & 15) ^ (((ln >> 4) & 3) << 2)) << 3));
        const long tb = (long)b * SEQ + n0 * 64;
        const bf16* qg = F.QR() + tb * RQK + h * 64; const bf16* kg = F.KDR() + tb * RQK + h * 64; const bf16* vg = F.VR() + tb * RVW + h * 128;
#define R2_ISSUE(i_) do { const unsigned bo_ = lds_base + ((i_) & 1) * R2_BUF + w * 1024; const long ro_ = (long)(i_) * 64; \
        dma16_asm(qg + (ro_ + 8 * w) * RQK + qk_src, bo_); dma16_asm(kg + (ro_ + 8 * w) * RQK + qk_src, bo_ + 8192); dma16_asm(kg + (ro_ + 8 * w) * RQK + kt_src, bo_ + 16384); \
        dma16_asm(vg + (ro_ + 4 * w) * RVW + v_src, bo_ + 24576); dma16_asm(vg + (ro_ + 32 + 4 * w) * RVW + v_src, bo_ + 24576 + 8192); } while (0)
        R2_ISSUE(0);
        f32x16 acc[2];
#pragma unroll
        for (int r = 0; r < 16; ++r) { acc[0][r] = 0.f; acc[1][r] = 0.f; }
        { const float G = fast_exp2(2048.0f * l2g); float coef = 1.f;
          for (int sp = seg - 1; sp >= 0; --sp) {
              const int up = u - seg + sp;
              const f32x4* ee = (const f32x4*)F.ST() + ((long)((up * 2 + 0) * 4 + db) * 8) * 64 + ln; const f32x4* eo = (const f32x4*)F.ST() + ((long)((up * 2 + 1) * 4 + db) * 8) * 64 + ln;
#pragma unroll
              for (int jb = 0; jb < 2; ++jb)
#pragma unroll
                  for (int q4 = 0; q4 < 4; ++q4) { const f32x4 a = ee[(4 * jb + q4) * 64], c = eo[(4 * jb + q4) * 64];
                      acc[jb][4 * q4] += coef * (g64 * a[0] + c[0]); acc[jb][4 * q4 + 1] += coef * (g64 * a[1] + c[1]); acc[jb][4 * q4 + 2] += coef * (g64 * a[2] + c[2]); acc[jb][4 * q4 + 3] += coef * (g64 * a[3] + c[3]); }
              coef *= G;
          } }
        const float cr = fast_exp2(l2g * (float)(32 * th + r32 + 1));
        const int xq = l16 >> 2, x1 = (l16 & 3) >> 1, x0 = l16 & 1;
        const unsigned ka_off = (unsigned)((4 * hi + xq) * 128 + 8 * x0), ka_sw = (unsigned)(((l16 >> 3) & 1) << 2), ka_c = (unsigned)(2 * g16 + x1);
        const unsigned vrd = (unsigned)((l16 >> 2) * 256 + 8 * (l16 & 1)), vrsw = (unsigned)((l16 >> 2) << 2), vrc = (unsigned)(2 * g16 + ((l16 & 3) >> 1));
#pragma unroll 1
        for (int i = 0; i < 32; ++i) {
            asm volatile("s_waitcnt vmcnt(0)\n\ts_barrier" ::: "memory");
            if (i + 1 < 32) R2_ISSUE(i + 1);
            LAS unsigned char* bufp = lds + (i & 1) * R2_BUF;
            const long tq = (long)b * SEQ + (n0 + i) * 64 + 32 * th + r32;
            u32x4 gq[2];
#pragma unroll
            for (int gp = 0; gp < 2; ++gp) gq[gp] = *(const u32x4*)(F.GR() + tq * RVW + h * 128 + 32 * db + 16 * gp + 8 * hi);
            bf16x8 qf[4], pp[4];
            { const LAS unsigned char* qrow = bufp + (32 * th + r32) * 128 + 8 * hi;
#pragma unroll
              for (int s = 0; s < 4; ++s) { const u32x2 a = *(const LAS u32x2*)(qrow + (((2 * s) ^ (r32 & 7)) << 4)), c = *(const LAS u32x2*)(qrow + (((2 * s + 1) ^ (r32 & 7)) << 4));
                  const u32x4 t4 = {a.x, a.y, c.x, c.y}; qf[s] = __builtin_bit_cast(bf16x8, t4); } }
#pragma unroll
            for (int kb = 0; kb < 2; ++kb) {
                bf16x8 kf[4];
                const LAS unsigned char* krow = bufp + 8192 + (32 * kb + r32) * 128 + 8 * hi;
#pragma unroll
                for (int s = 0; s < 4; ++s) { const u32x2 a = *(const LAS u32x2*)(krow + (((2 * s) ^ (r32 & 7)) << 4)), c = *(const LAS u32x2*)(krow + (((2 * s + 1) ^ (r32 & 7)) << 4));
                    const u32x4 t4 = {a.x, a.y, c.x, c.y}; kf[s] = __builtin_bit_cast(bf16x8, t4); }
                f32x16 sa;
#pragma unroll
                for (int r = 0; r < 16; ++r) sa[r] = 0.f;
#pragma unroll
                for (int s = 0; s < 4; ++s) sa = MFMA32(kf[s], qf[s], sa);
#pragma unroll
                for (int r = 0; r < 16; ++r) { const int k = 32 * kb + (r & 3) + 8 * (r >> 2) + 4 * hi, q = 32 * th + r32; const int ad = q > k ? q - k : k - q;
                    sa[r] *= fast_exp2(l2g * (float)(ad - 63 + k)); }
                pp[2 * kb] = pack8(sa, 0); pp[2 * kb + 1] = pack8(sa, 8);
            }
            s16x4 vlo[4], vhi[4], al[2][4], ah[2][4];
            { const unsigned vb_ = lds_off(bufp) + 24576 + 4 * hi * 256 + vrd + (((4 * db + vrc) ^ vrsw) << 4);
              vlo[0] = lds_tr16o<0>(vb_); vhi[0] = lds_tr16o<2048>(vb_); vlo[1] = lds_tr16o<4096>(vb_); vhi[1] = lds_tr16o<6144>(vb_);
              vlo[2] = lds_tr16o<8192>(vb_); vhi[2] = lds_tr16o<10240>(vb_); vlo[3] = lds_tr16o<12288>(vb_); vhi[3] = lds_tr16o<14336>(vb_); }
#pragma unroll
            for (int jb = 0; jb < 2; ++jb) { const unsigned kb_ = lds_off(bufp) + 16384 + ka_off + (((4 * jb + ka_c) ^ ka_sw) << 4);
              al[jb][0] = lds_tr16o<0>(kb_); ah[jb][0] = lds_tr16o<1024>(kb_); al[jb][1] = lds_tr16o<2048>(kb_); ah[jb][1] = lds_tr16o<3072>(kb_);
              al[jb][2] = lds_tr16o<4096>(kb_); ah[jb][2] = lds_tr16o<5120>(kb_); al[jb][3] = lds_tr16o<6144>(kb_); ah[jb][3] = lds_tr16o<7168>(kb_); }
            TR_WAIT();
            f32x16 o, oc;
#pragma unroll
            for (int r = 0; r < 16; ++r) { o[r] = 0.f; oc[r] = 0.f; }
#pragma unroll
            for (int s4 = 0; s4 < 4; ++s4) {
                const bf16x8 vf = {vlo[s4][0], vlo[s4][1], vlo[s4][2], vlo[s4][3], vhi[s4][0], vhi[s4][1], vhi[s4][2], vhi[s4][3]};
                o = MFMA32(vf, pp[s4], o);
            }
#pragma unroll
            for (int s = 0; s < 4; ++s) oc = MFMA32(pack8(acc[s >> 1], 8 * (s & 1)), qf[s], oc);
#pragma unroll
            for (int r = 0; r < 16; ++r) o[r] += cr * oc[r];
#pragma unroll
            for (int r = 0; r < 16; ++r) { acc[0][r] *= g64; acc[1][r] *= g64; }
#pragma unroll
            for (int s4 = 0; s4 < 4; ++s4) {
                const bf16x8 vf = {vlo[s4][0], vlo[s4][1], vlo[s4][2], vlo[s4][3], vhi[s4][0], vhi[s4][1], vhi[s4][2], vhi[s4][3]};
#pragma unroll
                for (int jb = 0; jb < 2; ++jb) {
                    const bf16x8 afr = {al[jb][s4][0], al[jb][s4][1], al[jb][s4][2], al[jb][s4][3], ah[jb][s4][0], ah[jb][s4][1], ah[jb][s4][2], ah[jb][s4][3]};
                    acc[jb] = MFMA32(afr, vf, acc[jb]);
                }
            }
            float sum = 0.f, sq = 0.f;
#pragma unroll
            for (int r = 0; r < 16; ++r) { sum += o[r]; sq += o[r] * o[r]; }
            sum += __shfl_xor(sum, 32); sq += __shfl_xor(sq, 32);
            LAS f32x2_t* stt = (LAS f32x2_t*)(lds + R2_STAT);
            if (hi == 0) stt[w * 32 + r32] = (f32x2_t){sum, sq};
            asm volatile("s_waitcnt lgkmcnt(0)\n\ts_barrier" ::: "memory");
            float ts = 0.f, tq2 = 0.f;
#pragma unroll
            for (int d = 0; d < 4; ++d) { const f32x2_t v = stt[(th * 4 + d) * 32 + r32]; ts += v[0]; tq2 += v[1]; }
            const float mean = ts * (1.f / 128.f);
            const float rstd = 1.0f / sqrtf(fmaxf(tq2 * (1.f / 128.f) - mean * mean, 0.f) + 1e-5f);
#pragma unroll
            for (int gp = 0; gp < 2; ++gp) {
                const u32x4 q4 = gq[gp];
                const auto a0 = __builtin_amdgcn_permlane32_swap(q4.x, q4.z, false, false), a1 = __builtin_amdgcn_permlane32_swap(q4.y, q4.w, false, false);
                u32x2 wv[2];
#pragma unroll
                for (int e = 0; e < 2; ++e) { const int g = 2 * gp + e; const unsigned gx = a0[e], gy = a1[e];
                    wv[e].x = cvtpk((o[4 * g] - mean) * rstd * bf2f(gx & 0xffffu), (o[4 * g + 1] - mean) * rstd * bf2f(gx >> 16));
                    wv[e].y = cvtpk((o[4 * g + 2] - mean) * rstd * bf2f(gy & 0xffffu), (o[4 * g + 3] - mean) * rstd * bf2f(gy >> 16)); }
                const auto s0 = __builtin_amdgcn_permlane32_swap(wv[0].x, wv[1].x, false, false), s1 = __builtin_amdgcn_permlane32_swap(wv[0].y, wv[1].y, false, false);
                const u32x4 w4 = {s0[0], s1[0], s0[1], s1[1]};
                *(u32x4*)(F.ACAT() + tq * KCAT + AW + h * 128 + 32 * db + 16 * gp + 8 * hi) = w4;
            }
        }
#undef R2_ISSUE
        __syncthreads();
    }
}
__device__ __forceinline__ void p2_scan_ref(Frame& F) {
    const int gw = blockIdx.x * 8 + F.wave, NGW = F.G * 8, lane = F.lane;
    for (int it = gw; it < BATCH * 8 * 128; it += NGW) {
        const int dv = it & 127, h = (it >> 7) & 7, b = it >> 10;
        const float g64 = fast_exp2(64.0f * log2gamma(h));
        float st = 0.f;
        for (int n = 0; n < NCH; ++n) {
            F.ST()[(((size_t)(b * 8 + h) * NCH + n) * 128 + dv) * 64 + lane] = (bf16)f2bf(st);
            const size_t t0 = (size_t)b * SEQ + n * 64;
            float a = 0.f;
            for (int j = 0; j < 64; ++j) a += bf2f(F.KDR()[(t0 + j) * RQK + h * 64 + lane]) * bf2f(F.VR()[(t0 + j) * RVW + h * 128 + dv]);
            st = st * g64 + a;
        }
    }
}
__device__ __forceinline__ void p3_ret_ref(Frame& F) {
    const int gw = blockIdx.x * 8 + F.wave, NGW = F.G * 8, lane = F.lane;
    LAS float* sw = (LAS float*)(F.lds + F.wave * 16384);
    for (int it = gw; it < BATCH * NCH * 8; it += NGW) {
        const int h = it & 7, n = (it >> 3) & (NCH - 1), b = it >> 10;
        const size_t t0 = (size_t)b * SEQ + n * 64, t = t0 + lane;
        const float l2g = log2gamma(h);
        float q[64]; load_row64(F.QR() + t * RQK + h * 64, q);
        for (int j = 0; j < 64; ++j) {
            const float s = dot_row64(q, F.KDR() + (t0 + j) * RQK + h * 64);
            const int ad = lane > j ? lane - j : j - lane;
            sw[j * 64 + lane] = s * fast_exp2(l2g * (float)(ad - 63 + j));
        }
        asm volatile("s_waitcnt lgkmcnt(0)" ::: "memory");
        const float cross = fast_exp2(l2g * (float)(lane + 1));
        const bf16* stp = F.ST() + ((size_t)(b * 8 + h) * NCH + n) * 8192;
        float sum = 0.f, sq = 0.f, mean = 0.f, rstd = 0.f;
        for (int pass = 0; pass < 2; ++pass) {
#pragma unroll 1
            for (int dv = 0; dv < 128; ++dv) {
                float o = 0.f;
#pragma unroll 4
                for (int j = 0; j < 64; ++j) o += sw[j * 64 + lane] * bf2f(F.VR()[(t0 + j) * RVW + h * 128 + dv]);
                o += cross * dot_row64(q, stp + dv * 64);
                if (pass == 0) { sum += o; sq += o * o; }
                else F.ACAT()[t * KCAT + AW + h * 128 + dv] = (bf16)f2bf((o - mean) * rstd * F.gn_gain[h * 128 + dv] * bf2f(F.GR()[t * RVW + h * 128 + dv]));
            }
            if (pass == 0) { mean = sum * (1.f / 128.f); const float var = fmaxf(sq * (1.f / 128.f) - mean * mean, 0.f); rstd = 1.0f / sqrtf(var + 1e-5f); }
        }
        asm volatile("s_waitcnt lgkmcnt(0)" ::: "memory");
    }
}
__device__ __forceinline__ void p7_final_norm(Frame& F) {
    const int gw = blockIdx.x * 8 + F.wave, NGW = F.G * 8;
    for (int m = gw; m < T; m += NGW) {
        const f32x4* xr = (const f32x4*)(F.TMP() + (size_t)m * DM) + F.lane; f32x4* orow = (f32x4*)(F.out + (size_t)m * DM) + F.lane;
        const f32x4* gr = (const f32x4*)F.final_gain + F.lane;
        f32x4 v[4]; float s = 0.f;
#pragma unroll
        for (int j = 0; j < 4; ++j) { v[j] = xr[64 * j]; s += (v[j].x * v[j].x + v[j].y * v[j].y) + (v[j].z * v[j].z + v[j].w * v[j].w); }
        const float r = 1.0f / sqrtf(wave_sum(s) * (1.f / DM) + 1e-6f);
#pragma unroll
        for (int j = 0; j < 4; ++j) { const f32x4 g = gr[64 * j]; orow[64 * j] = v[j] * r * g; }
    }
}


typedef __attribute__((address_space(1))) unsigned gu32;
#define RLX_AGENT __ATOMIC_RELAXED, __HIP_MEMORY_SCOPE_AGENT
#define XB_TMO      128
#define XB_XCNT(j)  (256  + 64 * (j))
#define XB_XSUB(j)  (1280 + 64 * (j))
#define XB_XGEN(j)  (2304 + 64 * (j))
#define XB_TOP      3328
#define XB_TOPGEN   3392
#define XCD_BAR_WORDS 3456
#define XB_SPIN_CAP (1u << 18)

__device__ __forceinline__ unsigned xb_ld(unsigned* p)              { return __hip_atomic_load(p, __ATOMIC_RELAXED, __HIP_MEMORY_SCOPE_AGENT); }
__device__ __forceinline__ unsigned xb_add(unsigned* p, unsigned v) { return __hip_atomic_fetch_add(p, v, __ATOMIC_RELAXED, __HIP_MEMORY_SCOPE_AGENT); }
__device__ __forceinline__ unsigned xb_xcc_id() { return (unsigned)__builtin_amdgcn_s_getreg((3 << 11) | 20) & 0xFu; }
#define XB_SPIN(cond, bar) do { unsigned _sp = 0; while (cond) { __builtin_amdgcn_s_sleep(1); \
    if ((++_sp & 255u) == 0u) { if (xb_ld(&(bar)[XB_TMO])) break; if (_sp > XB_SPIN_CAP) { atomicAdd(&(bar)[XB_TMO], 1u); break; } } } } while (0)

struct XcdBarrier {
    unsigned* bar; unsigned x;
    volatile LAS unsigned* st;
};

__device__ __forceinline__ XcdBarrier xcd_barrier_post(unsigned* bar, volatile LAS unsigned* st, bool leader) {
    XcdBarrier b; b.bar = bar; b.x = xb_xcc_id(); b.st = st;
    if (leader) (void)xb_add(&bar[XB_XCNT(b.x)], 1u);
    return b;
}
__device__ __forceinline__ void xcd_barrier_complete(unsigned* bar, unsigned x, unsigned& nloc, unsigned& nx) {
    const unsigned G = gridDim.x * gridDim.y * gridDim.z;
    unsigned sum, cnt, mine, sp = 0u;
    for (;;) {
        sum = 0u; cnt = 0u; mine = 0u;
#pragma unroll
        for (unsigned j = 0; j < 16; ++j) { const unsigned c = xb_ld(&bar[XB_XCNT(j)]); sum += c; cnt += (c > 0u) ? 1u : 0u; mine = (j == x) ? c : mine; }
        if (sum == G) break;
        __builtin_amdgcn_s_sleep(1);
        if ((++sp & 255u) == 0u) { if (xb_ld(&bar[XB_TMO])) break; if (sp > XB_SPIN_CAP) { atomicAdd(&bar[XB_TMO], 1u); break; } }
    }
    nloc = mine > 0u ? mine : 1u; nx = cnt > 0u ? cnt : 1u;
}

__device__ __forceinline__ void xcd_barrier(const XcdBarrier& b, bool leader) {
    asm volatile("s_waitcnt vmcnt(0)" ::: "memory");
    __syncthreads();
    if (leader) {
        unsigned* bar = b.bar;
        __builtin_amdgcn_s_waitcnt(0);
        unsigned nloc = b.st[0], nx = b.st[1];
        if (nloc == 0u) { xcd_barrier_complete(bar, b.x, nloc, nx); b.st[0] = nloc; b.st[1] = nx; }
        const unsigned old = xb_add(&bar[XB_XSUB(b.x)], 1u);
        const unsigned gen = old / nloc;
        if (old + 1u == (gen + 1u) * nloc) {
            __builtin_amdgcn_fence(__ATOMIC_RELEASE, "agent");
            asm volatile("s_waitcnt vmcnt(0)" ::: "memory");
            const unsigned og = xb_add(&bar[XB_TOP], 1u);
            const unsigned tg = og / nx;
            if (og + 1u == (tg + 1u) * nx) xb_add(&bar[XB_TOPGEN], 1u);
            else XB_SPIN(xb_ld(&bar[XB_TOPGEN]) == tg, bar);
            __builtin_amdgcn_fence(__ATOMIC_ACQUIRE, "agent");
            xb_add(&bar[XB_XGEN(b.x)], 1u);
            asm volatile("s_waitcnt vmcnt(0)" ::: "memory");
        } else {
            XB_SPIN(xb_ld(&bar[XB_XGEN(b.x)]) == gen, bar);
            __builtin_amdgcn_fence(__ATOMIC_ACQUIRE, "agent");
            asm volatile("s_waitcnt vmcnt(0)" ::: "memory");
        }
    }
    __syncthreads();
}


constexpr int MISC_OFF = 155136;

__global__ void __launch_bounds__(512, 2) fwd(Args args) {
    extern __shared__ __attribute__((aligned(16))) unsigned char lds[];
    Frame F;
    F.lds = (LAS unsigned char*)lds;
    F.tid = threadIdx.x; F.lane = F.tid & 63; F.wave = __builtin_amdgcn_readfirstlane(F.tid >> 6); F.G = gridDim.x;
    F.x = args.in[0]; F.norm_gain = args.in[1]; F.w_in = args.in[2]; F.rel_bias = args.in[3]; F.gn_gain = args.in[4];
    F.w_out_attn = args.in[5]; F.w_out_ret = args.in[6]; F.w_out = args.in[7]; F.final_gain = args.in[8]; F.out = args.out;
    unsigned char* ws = args.ws; F.ws = ws;
    volatile LAS unsigned* MISC = (volatile LAS unsigned*)(F.lds + MISC_OFF);
    if (F.tid < 32) MISC[F.tid] = 0u;
    __syncthreads();
    XcdBarrier bar = xcd_barrier_post((unsigned*)(ws + WS_CTL) + 4096, MISC + 8, F.tid == 0);
#define GRID_BAR() do { const int t_ = (F.wave << 6) | lane_id_asm(); xcd_barrier(bar, t_ == 0); { unsigned long w_ = (unsigned long)args.ws; asm volatile("" : "+s"(w_)); F.ws = (unsigned char*)(__attribute__((address_space(1))) unsigned char*)w_; F.tid = t_; F.lane = t_ & 63; } } while (0)
    p0_prologue(F); GRID_BAR();
    { pg8::Gemm g{F.H(), F.WinT(), T, 20 * 256, DM, DM, DM}; pg8::StaticOrder S; S.init(T, 20 * 256, F.G, (int)blockIdx.x);
      Epi1 E{F.QA(), F.KA(), F.VA(), F.GA(), F.QR(), F.KDR(), F.VR(), F.GR(), F.SA(), F.SR(), 0, F.gn_gain};
      pg8::gemm_phase<Epi1, pg8::StaticOrder, true, true>(F.lds, g, S, E, F.wave); }
    GRID_BAR();
    if (((int)blockIdx.x >> 7) == 0) { p2_seg_state(F); p5_attn_mfma(F); }
    else { p5_attn_mfma(F); __syncthreads(); p2_seg_state(F); }
    GRID_BAR();
#define GATE_GEMM() do { pg8::Gemm g{F.H(), F.WinT() + (size_t)20 * 256 * DM, T, 8 * 256, DM, DM, DM}; pg8::StaticOrder S; S.init(T, 8 * 256, F.G, (int)blockIdx.x); \
      Epi1 E{F.QA(), F.KA(), F.VA(), F.GA(), F.QR(), F.KDR(), F.VR(), F.GR(), F.SA(), F.SR(), 20, F.gn_gain}; \
      pg8::gemm_phase<Epi1, pg8::StaticOrder, true, true>(F.lds, g, S, E, F.wave); } while (0)
    if ((((int)blockIdx.x >> 3) & 1) == 0) { p3_ret2(F); __syncthreads(); GATE_GEMM(); }
    else { GATE_GEMM(); __syncthreads(); p3_ret2(F); }
#undef GATE_GEMM
    GRID_BAR();
    { pg8::Gemm g{F.ACAT(), F.WcatT(), T, DM, KCAT, KCAT, KCAT}; pg8::StaticOrder S; S.init(T, DM, F.G, (int)blockIdx.x);
      Epi2 E{F.SA(), F.SR(), F.MIXED()};
      pg8::gemm_phase<Epi2, pg8::StaticOrder, true, true>(F.lds, g, S, E, F.wave); }
    GRID_BAR();
    { pg8::Gemm g{F.MIXED(), F.WoT(), T, DM, DM, DM, DM}; pg8::StaticOrder S; S.init(T, DM, F.G, (int)blockIdx.x);
      Epi3n E{F.x, F.out, F.final_gain, (float*)(F.ws + WS_XBUF), (unsigned*)(F.ws + WS_CTL) + CW_PANEL, F.lds};
      pg8::gemm_phase<Epi3n, pg8::StaticOrder, true, true>(F.lds, g, S, E, F.wave); }
#undef GRID_BAR
}

extern "C" void kernel_launch(void* const* d_in, const int* in_sizes, int n_in, void* d_out, int out_size, void* d_ws, size_t ws_size, hipStream_t stream) {
    static int grid = 0;
    if (grid == 0) {
        if (n_in != 9 || in_sizes[0] != T * DM || out_size != T * DM || ws_size < WS_END) { fprintf(stderr, "kernel_launch: unexpected shapes / workspace (n_in %d, in0 %d, out %d, ws %zu); nothing launched\n", n_in, n_in > 0 ? in_sizes[0] : -1, out_size, ws_size); grid = -1; return; }
        int dev = 0, cus = 0;
        if (hipGetDevice(&dev) != hipSuccess || hipDeviceGetAttribute(&cus, hipDeviceAttributeMultiprocessorCount, dev) != hipSuccess) { grid = -1; return; }
        if (hipFuncSetAttribute((const void*)fwd, hipFuncAttributeMaxDynamicSharedMemorySize, LDS_BYTES) != hipSuccess) { fprintf(stderr, "kernel_launch: hipFuncSetAttribute failed\n"); grid = -1; return; }
        (void)hipGetLastError();
        grid = cus;
    }
    if (grid < 0) return;
    if (hipMemsetAsync((char*)d_ws + WS_CTL, 0, 1 * MiB, stream) != hipSuccess) return;
    Args a{};
    for (int i = 0; i < 9; ++i) a.in[i] = (const float*)d_in[i];
    a.out = (float*)d_out; a.ws = (unsigned char*)d_ws;
    hipLaunchKernelGGL(fwd, dim3(grid), dim3(512), LDS_BYTES, stream, a);
}
```

```cpp
#include <hip/hip_runtime.h>
#include <cstdio>
#include <cstdint>

__device__ __forceinline__ int lane_id_asm() { int l_; asm volatile("v_mbcnt_lo_u32_b32 %0, -1, 0\n\tv_mbcnt_hi_u32_b32 %0, -1, %0" : "=v"(l_)); return l_; }
namespace pg8 {
#define PG8_LAS __attribute__((address_space(3)))
typedef unsigned short bf16_t;
typedef short bf16x8 __attribute__((ext_vector_type(8)));
typedef float f32x4 __attribute__((ext_vector_type(4)));
typedef unsigned u32x4 __attribute__((ext_vector_type(4)));
typedef unsigned u32x2 __attribute__((ext_vector_type(2)));
constexpr int BM = 256, BK = 64, HALF = 128, HTB = HALF * BK * 2  , STAGE_BYTES = 8 * HTB, NXCD = 8, WGM = 8;

__host__ __device__ __forceinline__ int lds_byte(int r, int c) { const int st = (r >> 4) * 2 + (c >> 5), rr = r & 15, cc = c & 31, ob = rr * 64 + cc * 2; return st * 1024 + (ob ^ (((ob >> 9) & 1) << 5)); }
__host__ __device__ __forceinline__ void stage_rc(int b, int& R, int& C) { const int st = b / 1024, sb = b % 1024, swz = sb ^ (((sb >> 9) & 1) << 5); R = (st >> 1) * 16 + swz / 64; C = (st & 1) * 32 + (swz % 64) / 2; }
__host__ __device__ __forceinline__ int perm32(int rho) { const int n = rho >> 4, i = rho & 15; return 8 * (i >> 2) + 4 * n + (i & 3); }

struct Unit { int pm, pn; };
struct Gemm { const bf16_t* A; const bf16_t* Bt; int M, N, K, lda, ldb; };

struct StaticOrder {
    int nM, nN, nwg, G, c;
    __host__ __device__ void init(int M, int N, int G_, int c_) { nM = M / BM; nN = N / BM; nwg = nM * nN; G = G_; c = c_; }
    __host__ __device__ bool next(int i, Unit& u) const {
        const long L = (long)i * G + c; if (L >= nwg) return false;
        int wgid = (int)L; { const int q = nwg / NXCD, r = nwg % NXCD, xcd = wgid % NXCD, off = wgid / NXCD; wgid = (xcd < r ? xcd * (q + 1) : r * (q + 1) + (xcd - r) * q) + off; }
        const int nig = WGM * nN, gid = wgid / nig, fm = gid * WGM, gsz = (nM - fm) < WGM ? (nM - fm) : WGM;
        u.pm = fm + ((wgid % nig) % gsz); u.pn = (wgid % nig) / gsz; return true;
    }
    __device__ __forceinline__ void a_ready(const Unit&) const {}
    __device__ __forceinline__ void done(const Unit&) const {}
};

typedef float f32x2_cv __attribute__((ext_vector_type(2))); typedef __bf16 bf16x2_cv __attribute__((ext_vector_type(2)));
__device__ __forceinline__ unsigned cvt_pk_bf16(float lo, float hi) { f32x2_cv v = {lo, hi}; bf16x2_cv b = __builtin_convertvector(v, bf16x2_cv); return __builtin_bit_cast(unsigned, b); }
__device__ __forceinline__ float bf_lo(unsigned w) { return __uint_as_float(w << 16); }
__device__ __forceinline__ float bf_hi(unsigned w) { return __uint_as_float(w & 0xffff0000u); }

template <class Epi, class Sched, bool ALIGN_EPI = false, bool SP2 = false>
__device__ __forceinline__ void gemm_phase(PG8_LAS unsigned char* lds, const Gemm g, const Sched& S, const Epi& E, int wave_id) {
    const int tid_ = (__builtin_amdgcn_readfirstlane(wave_id) << 6) | lane_id_asm();
    const int tid = tid_, wid = __builtin_amdgcn_readfirstlane(tid >> 6), lane = tid & 63, wr = wid >> 2, wc = wid & 3, fr = lane & 15, fq = lane >> 4;
    const int K = g.K, nt = K / BK;
    unsigned voffA[2], voffB[2];
#pragma unroll
    for (int i = 0; i < 2; ++i) { int R, C; stage_rc(tid * 16 + i * 8192, R, C); const int Rb = Epi::PERM ? ((R & ~31) + perm32(R & 31)) : R;
        voffA[i] = (unsigned)(R * g.lda + C) * 2u; voffB[i] = (unsigned)(Rb * g.ldb + C) * 2u; }
    const size_t kstep = (size_t)(BK * 2);
    const size_t hstepA = (size_t)HALF * g.lda * 2, hstepB = (size_t)HALF * g.ldb * 2;
    const size_t tstepA = 2 * hstepA, tstepB = 2 * hstepB;
    const unsigned ldsw = (unsigned)wid * 1024u;
    const int aoff = lds_byte(wr * 64 + fr, fq * 8), boff = lds_byte(wc * 32 + fr, fq * 8);
#define PG8_SA(b, h) (((b) * 2 + (h)) * HTB)
#define PG8_SB(b, h) ((4 + (b) * 2 + (h)) * HTB)
    const unsigned lds_b0 = (unsigned)__builtin_amdgcn_readfirstlane((int)(unsigned)(unsigned long long)lds) + ldsw;
#define PG8_STAGE(bufoff, gbase, voff) do { _Pragma("unroll") for (int _i = 0; _i < 2; ++_i) \
        asm volatile("s_mov_b32 m0, %1\n\ts_nop 0\n\tglobal_load_lds_dwordx4 %0, off" :: "v"((const char*)(gbase) + (voff)[_i]), "s"(lds_b0 + (unsigned)(bufoff) + (unsigned)(_i * 8192)) : "memory"); } while (0)
#define PG8_LDA(dst, b, h) do { _Pragma("unroll") for (int m = 0; m < 4; ++m) _Pragma("unroll") for (int k = 0; k < 2; ++k) dst[m][k] = *(const PG8_LAS bf16x8*)(lds + PG8_SA(b, h) + aoff + m * 2048 + k * 1024); } while (0)
#define PG8_LDB(dst, b, h) do { _Pragma("unroll") for (int n = 0; n < 2; ++n) _Pragma("unroll") for (int k = 0; k < 2; ++k) dst[n][k] = *(const PG8_LAS bf16x8*)(lds + PG8_SB(b, h) + boff + n * 2048 + k * 1024); } while (0)
#define PG8_MMA(ai, bj, At, Bt) do { __builtin_amdgcn_s_setprio(1); _Pragma("unroll") for (int m = 0; m < 4; ++m) _Pragma("unroll") for (int n = 0; n < 2; ++n) _Pragma("unroll") for (int k = 0; k < 2; ++k) \
        acc[ai][bj][m][n] = __builtin_amdgcn_mfma_f32_16x16x32_bf16(Bt[n][k], At[m][k], acc[ai][bj][m][n], 0, 0, 0); __builtin_amdgcn_s_setprio(0); } while (0)
#define PG8_WAIT_V(n) asm volatile("s_waitcnt vmcnt(" #n ")" ::: "memory")
#define PG8_WAIT_L(n) asm volatile("s_waitcnt lgkmcnt(" #n ")" ::: "memory")
#define PG8_BAR __builtin_amdgcn_s_barrier()
#define PG8_SCHED __builtin_amdgcn_sched_barrier(0)
    Unit cur, nxt; int ui = 0;
    if (!S.next(0, cur)) return;
    f32x4 acc[2][2][4][2];
#pragma unroll
    for (int a = 0; a < 2; ++a)
#pragma unroll
        for (int b = 0; b < 2; ++b)
#pragma unroll
            for (int m = 0; m < 4; ++m)
#pragma unroll
                for (int n = 0; n < 2; ++n) acc[a][b][m][n] = (f32x4){0.f, 0.f, 0.f, 0.f};
    bf16x8 At[4][2], B0[2][2], B1[2][2];
    const char* cA = (const char*)g.A + (size_t)cur.pm * tstepA; const char* cB = (const char*)g.Bt + (size_t)cur.pn * tstepB;
#define PG8_S0(u_) (Epi::CYCLIC ? 2 * ((((u_).pm & 7) + 2 * ((u_).pn & 3)) & 3) : 0)
    int s0 = PG8_S0(cur);
    S.a_ready(cur);
    { const char* pA_ = cA + (size_t)s0 * kstep; const char* pB_ = cB + (size_t)s0 * kstep;
    if constexpr (SP2) {
        PG8_STAGE(PG8_SB(0, 0), pB_, voffB); PG8_STAGE(PG8_SB(0, 1), pB_ + hstepB, voffB); PG8_STAGE(PG8_SA(0, 0), pA_, voffA); PG8_STAGE(PG8_SA(0, 1), pA_ + hstepA, voffA);
        if (wr == 1) PG8_BAR;
        PG8_WAIT_V(2); PG8_BAR;
        PG8_STAGE(PG8_SB(1, 0), pB_ + kstep, voffB); PG8_STAGE(PG8_SA(1, 0), pA_ + kstep, voffA); PG8_STAGE(PG8_SB(1, 1), pB_ + hstepB + kstep, voffB);
        PG8_WAIT_V(6); PG8_BAR;
    } else {
        PG8_STAGE(PG8_SB(0, 0), pB_, voffB); PG8_STAGE(PG8_SA(0, 0), pA_, voffA); PG8_STAGE(PG8_SB(0, 1), pB_ + hstepB, voffB); PG8_STAGE(PG8_SA(0, 1), pA_ + hstepA, voffA);
        if (wr == 1) PG8_BAR;
        PG8_WAIT_V(4); PG8_BAR;
        PG8_STAGE(PG8_SB(1, 0), pB_ + kstep, voffB); PG8_STAGE(PG8_SA(1, 0), pA_ + kstep, voffA); PG8_STAGE(PG8_SB(1, 1), pB_ + hstepB + kstep, voffB);
        PG8_WAIT_V(6); PG8_BAR;
    }
    }
    for (;;) {
        const bool has_next = S.next(ui + 1, nxt);
        const char* nA = has_next ? (const char*)g.A + (size_t)nxt.pm * tstepA : cA; const char* nB = has_next ? (const char*)g.Bt + (size_t)nxt.pn * tstepB : cB;
        const int s0n = has_next ? PG8_S0(nxt) : s0;
        int pt = s0;
        for (int t = 0; t < nt; t += 2) {
            if constexpr (Epi::MID_T > 0) { if (t == Epi::MID_T) E.mid(acc, cur, wr, wc, fr, fq); }
            const bool last = (t == nt - 2);
            const char* a1 = cA + (size_t)(pt + 1) * kstep;
            const int p2 = (pt + 2 == nt) ? 0 : pt + 2;
            const char* a2 = last ? nA + (size_t)s0n * kstep : cA + (size_t)p2 * kstep; const char* b2 = last ? nB + (size_t)s0n * kstep : cB + (size_t)p2 * kstep;
            pt = p2;
            const char* a3 = a2 + kstep; const char* b3 = b2 + kstep;
            if (last && has_next) S.a_ready(nxt);
            if constexpr (SP2) {
            PG8_LDB(B0, 0, 0); PG8_LDB(B1, 0, 1); PG8_SCHED; PG8_LDA(At, 0, 0); PG8_STAGE(PG8_SA(1, 1), a1 + hstepA, voffA);
            PG8_WAIT_V(8); PG8_WAIT_L(0); PG8_BAR; PG8_MMA(0, 0, At, B0); PG8_MMA(0, 1, At, B1); PG8_BAR; PG8_SCHED;
            PG8_LDA(At, 0, 1); PG8_STAGE(PG8_SB(0, 0), b2, voffB); PG8_STAGE(PG8_SB(0, 1), b2 + hstepB, voffB); PG8_STAGE(PG8_SA(0, 0), a2, voffA);
            PG8_WAIT_V(8); PG8_WAIT_L(0); PG8_BAR; PG8_MMA(1, 0, At, B0); PG8_MMA(1, 1, At, B1); PG8_BAR; PG8_SCHED;
            PG8_LDB(B0, 1, 0); PG8_LDB(B1, 1, 1); PG8_SCHED; PG8_LDA(At, 1, 0); PG8_STAGE(PG8_SA(0, 1), a2 + hstepA, voffA);
            PG8_WAIT_V(8); PG8_WAIT_L(0); PG8_BAR; PG8_MMA(0, 0, At, B0); PG8_MMA(0, 1, At, B1); PG8_BAR; PG8_SCHED;
            PG8_LDA(At, 1, 1); PG8_STAGE(PG8_SB(1, 0), b3, voffB); PG8_STAGE(PG8_SB(1, 1), b3 + hstepB, voffB); PG8_STAGE(PG8_SA(1, 0), a3, voffA);
            PG8_WAIT_V(8); PG8_WAIT_L(0); PG8_BAR; PG8_MMA(1, 0, At, B0); PG8_MMA(1, 1, At, B1); PG8_BAR; PG8_SCHED;
            } else {
            PG8_LDB(B0, 0, 0); PG8_SCHED; PG8_LDA(At, 0, 0); PG8_STAGE(PG8_SA(1, 1), a1 + hstepA, voffA);
            PG8_WAIT_L(8); PG8_BAR; PG8_WAIT_L(0); PG8_MMA(0, 0, At, B0); PG8_BAR; PG8_SCHED;
            PG8_LDB(B1, 0, 1); PG8_STAGE(PG8_SB(0, 0), b2, voffB);
            PG8_BAR; PG8_WAIT_L(0); PG8_MMA(0, 1, At, B1); PG8_BAR;
            PG8_LDA(At, 0, 1); PG8_STAGE(PG8_SA(0, 0), a2, voffA);
            PG8_BAR; PG8_WAIT_L(0); PG8_MMA(1, 0, At, B0); PG8_BAR; PG8_SCHED;
            PG8_STAGE(PG8_SB(0, 1), b2 + hstepB, voffB);
            PG8_WAIT_V(6); PG8_BAR; PG8_MMA(1, 1, At, B1); PG8_BAR;
            PG8_LDB(B0, 1, 0); PG8_SCHED; PG8_LDA(At, 1, 0); PG8_STAGE(PG8_SA(0, 1), a2 + hstepA, voffA);
            PG8_WAIT_L(8); PG8_BAR; PG8_WAIT_L(0); PG8_MMA(0, 0, At, B0); PG8_BAR; PG8_SCHED;
            PG8_LDB(B1, 1, 1); PG8_STAGE(PG8_SB(1, 0), b3, voffB);
            PG8_BAR; PG8_WAIT_L(0); PG8_MMA(0, 1, At, B1); PG8_BAR;
            PG8_LDA(At, 1, 1); PG8_STAGE(PG8_SA(1, 0), a3, voffA);
            PG8_BAR; PG8_WAIT_L(0); PG8_MMA(1, 0, At, B0); PG8_BAR; PG8_SCHED;
            PG8_STAGE(PG8_SB(1, 1), b3 + hstepB, voffB);
            PG8_WAIT_V(6); PG8_BAR; PG8_MMA(1, 1, At, B1); PG8_BAR;
            }
        }
        if constexpr (ALIGN_EPI) { if (wr == 0) PG8_BAR; }
        if constexpr (!Epi::AFTER_DRAIN) { E(acc, cur, wr, wc, fr, fq); S.done(cur); }
        if (!has_next) break;
#pragma unroll
        for (int a = 0; a < 2; ++a)
#pragma unroll
            for (int b = 0; b < 2; ++b)
#pragma unroll
                for (int m = 0; m < 4; ++m)
#pragma unroll
                    for (int n = 0; n < 2; ++n) acc[a][b][m][n] = (f32x4){0.f, 0.f, 0.f, 0.f};
        cur = nxt; cA = nA; cB = nB; s0 = s0n; ++ui;
        if constexpr (ALIGN_EPI) { if (wr == 1) PG8_BAR; }
    }
    PG8_WAIT_V(0);
    if constexpr (!ALIGN_EPI) { if (wr == 0) PG8_BAR; }
    PG8_BAR;
    if constexpr (Epi::AFTER_DRAIN) { E.fused(acc, cur, wr, wc, fr, fq, lds, wid, lane); S.done(cur); }
#undef PG8_S0
#undef PG8_SA
#undef PG8_SB
#undef PG8_STAGE
#undef PG8_LDA
#undef PG8_LDB
#undef PG8_MMA
#undef PG8_WAIT_V
#undef PG8_WAIT_L
#undef PG8_BAR
#undef PG8_SCHED
}
}

typedef unsigned short bf16;
typedef float f32x4 __attribute__((ext_vector_type(4)));
typedef unsigned u32x4 __attribute__((ext_vector_type(4)));
typedef unsigned u32x2 __attribute__((ext_vector_type(2)));
#define LAS __attribute__((address_space(3)))
constexpr int BATCH = 8, SEQ = 8192, DM = 1024, T = BATCH * SEQ, NIN = 7168, NCH = SEQ / 64;
constexpr int AW = 512, RQK = 512, RVW = 1024, KCAT = 1536;
constexpr float C2 = 0.18033688011112042f;
constexpr float LOG2E = 1.4426950408889634f;
constexpr size_t MiB = 1u << 20;
constexpr size_t WS_CTL = 0, WS_WIN = 1 * MiB, WS_WCAT = 16 * MiB, WS_WO = 20 * MiB;
constexpr size_t WS_H = 24 * MiB, WS_ACAT = 152 * MiB;
constexpr size_t WS_QR = 344 * MiB, WS_KDR = 408 * MiB, WS_VR = 472 * MiB, WS_GR = 600 * MiB, WS_ST = 728 * MiB;
constexpr size_t WS_QA = 344 * MiB, WS_KA = 408 * MiB, WS_VA = 472 * MiB, WS_GA = 536 * MiB;
constexpr size_t WS_SA = 344 * MiB, WS_SR = 472 * MiB, WS_TMP = 600 * MiB, WS_MIXED = 24 * MiB, WS_END = 856 * MiB;
constexpr int LDS_BYTES = 155648;
constexpr size_t WS_XBUF = 22 * MiB;
constexpr int CW_PANEL = 32768;
constexpr int XCH_OFF = 131072;

__device__ __forceinline__ double rope_rev_freq(int w, int fq, int i) {
    const double f0 = 0.15915494309189535;
    const double a = (w == 0) ? 1.0 : 0.01000000000000001;
    const double b = (fq == 0) ? 1.0 : (fq == 1) ? 0.316227766016838 : (fq == 2) ? 0.10000000000000005 : 0.03162277660168382;
    const double c = (i == 0) ? 1.0 : (i == 1) ? 0.7498942093324559 : (i == 2) ? 0.5623413251903492 : 0.42169650342858234;
    return f0 * a * b * c;
}
__device__ __forceinline__ float log2gamma(int h) {
    const float tb[8] = {-0.04580368961312479f, -0.02272007650008353f, -0.011315313227834146f, -0.005646563141142063f, -0.0028205190623786626f, -0.0014095702546713536f, -0.0007046129765893727f, -0.0003522634716290214f};
    float r = tb[0];
#pragma unroll
    for (int i = 1; i < 8; ++i) r = (h == i) ? tb[i] : r;
    return r;
}

__device__ __forceinline__ float bf2f(unsigned v) { return __uint_as_float(v << 16); }
__device__ __forceinline__ unsigned f2bf(float f) { unsigned u = __float_as_uint(f); return (u + 0x7fffu + ((u >> 16) & 1u)) >> 16; }
__device__ __forceinline__ unsigned pk2(float lo, float hi) { return f2bf(lo) | (f2bf(hi) << 16); }
__device__ __forceinline__ float fast_exp2(float x) { return __builtin_amdgcn_exp2f(x); }
__device__ __forceinline__ float sigmoidf_(float x) { return __builtin_amdgcn_rcpf(1.0f + fast_exp2(-x * LOG2E)); }

struct Epi1 {
    static constexpr bool PERM = true, AFTER_DRAIN = false, CYCLIC = true; static constexpr int MID_T = 0;
    bf16 *QA, *KA, *VA, *GA, *QR, *KDR, *VR, *GR, *SA, *SR; int pn_off; const float* gn;
    template <int MODE> __device__ __forceinline__ void body(const pg8::f32x4 (&acc)[2][2][4][2], const pg8::Unit& u, int wr, int wc, int fr, int fq, bf16* base, int ld, int colt, float sc, int head0) const {
        const int row0 = u.pm * 256 + wr * 64 + fr;
        double fr4[4];
        float l2g[2] = {0.f, 0.f};
        if ((MODE == 3 || MODE == 4)) {
            const int w = wc & 1;
#pragma unroll
            for (int i = 0; i < 4; ++i) fr4[i] = rope_rev_freq(w, fq, i);
            if (MODE == 4) { l2g[0] = log2gamma(head0 + (wc >> 1)); l2g[1] = log2gamma(head0 + 2 + (wc >> 1)); }
        }
#pragma unroll
        for (int ai = 0; ai < 2; ++ai)
#pragma unroll
            for (int m = 0; m < 4; ++m) {
                const int row = row0 + ai * 128 + m * 16;
                float cs[4], sn[4];
                if ((MODE == 3 || MODE == 4)) {
                    const int pos = row & (SEQ - 1);
#pragma unroll
                    for (int i = 0; i < 4; ++i) { double rv = (double)pos * fr4[i]; rv -= __builtin_floor(rv); const float rf = (float)rv; cs[i] = __builtin_amdgcn_cosf(rf); sn[i] = __builtin_amdgcn_sinf(rf); }
                }
#pragma unroll
                for (int bj = 0; bj < 2; ++bj) {
                    pg8::f32x4 v0 = acc[ai][bj][m][0], v1 = acc[ai][bj][m][1];
                    if (MODE == 0) { v0 = v0 * sc; v1 = v1 * sc; }
                    if (MODE == 1 || MODE == 6) {
#pragma unroll
                        for (int i = 0; i < 4; ++i) { v0[i] = v0[i] * sigmoidf_(v0[i]); v1[i] = v1[i] * sigmoidf_(v1[i]); }
                        if (MODE == 6) { const pg8::f32x4 g0 = *(const pg8::f32x4*)(gn + colt + bj * 128 + wc * 32 + 8 * fq), g1 = *(const pg8::f32x4*)(gn + colt + bj * 128 + wc * 32 + 8 * fq + 4); v0 = v0 * g0; v1 = v1 * g1; }
                    }
                    if (MODE == 2) {
#pragma unroll
                        for (int i = 0; i < 4; ++i) { v0[i] = sigmoidf_(v0[i]); v1[i] = sigmoidf_(v1[i]); }
                    }
                    if ((MODE == 3 || MODE == 4)) {
                        float f = 0.125f;
                        if (MODE == 4) f = fast_exp2((float)(63 - (row & 63)) * l2g[bj]);
#pragma unroll
                        for (int i = 0; i < 4; ++i) { const float x1 = v0[i], x2 = v1[i]; v0[i] = (x1 * cs[i] - x2 * sn[i]) * f; v1[i] = (x1 * sn[i] + x2 * cs[i]) * f; }
                    }
                    pg8::u32x4 w; w.x = pg8::cvt_pk_bf16(v0[0], v0[1]); w.y = pg8::cvt_pk_bf16(v0[2], v0[3]); w.z = pg8::cvt_pk_bf16(v1[0], v1[1]); w.w = pg8::cvt_pk_bf16(v1[2], v1[3]);
                    *(pg8::u32x4*)(base + (size_t)row * ld + colt + bj * 128 + wc * 32 + 8 * fq) = w;
                }
            }
    }
    __device__ __forceinline__ void body_gate(const pg8::f32x4 (&acc)[2][2][4][2], const pg8::Unit& u, int wr, int wc, int fr, int fq, int pg) const {
        const int row0 = u.pm * 256 + wr * 64 + fr, col = pg * 128 + wc * 32 + 8 * fq;
#pragma unroll
        for (int ai = 0; ai < 2; ++ai)
#pragma unroll
            for (int m = 0; m < 4; ++m) {
                const size_t off = (size_t)(row0 + ai * 128 + m * 16) * 1024 + col;
                float ra[8], sr[8];
#pragma unroll
                for (int n = 0; n < 2; ++n)
#pragma unroll
                    for (int i = 0; i < 4; ++i) { const float ea = fast_exp2(fminf(-acc[ai][0][m][n][i] * LOG2E, 80.f)), er = fast_exp2(fminf(-acc[ai][1][m][n][i] * LOG2E, 80.f));
                        const float s = __builtin_amdgcn_rcpf(1.0f + er); sr[4 * n + i] = s; ra[4 * n + i] = (1.0f + er) * __builtin_amdgcn_rcpf(1.0f + ea); }
                pg8::u32x4 w; w.x = pg8::cvt_pk_bf16(ra[0], ra[1]); w.y = pg8::cvt_pk_bf16(ra[2], ra[3]); w.z = pg8::cvt_pk_bf16(ra[4], ra[5]); w.w = pg8::cvt_pk_bf16(ra[6], ra[7]);
                *(pg8::u32x4*)(SA + off) = w;
                w.x = pg8::cvt_pk_bf16(sr[0], sr[1]); w.y = pg8::cvt_pk_bf16(sr[2], sr[3]); w.z = pg8::cvt_pk_bf16(sr[4], sr[5]); w.w = pg8::cvt_pk_bf16(sr[6], sr[7]);
                *(pg8::u32x4*)(SR + off) = w;
            }
    }
    __device__ __forceinline__ void operator()(const pg8::f32x4 (&acc)[2][2][4][2], const pg8::Unit& u, int wr, int wc, int fr, int fq) const {
        const int pn = u.pn + pn_off;
        if (pn < 2)        body<0>(acc, u, wr, wc, fr, fq, QA, 512, (pn - 0) * 256, C2, 0);
        else if (pn < 4)   body<0>(acc, u, wr, wc, fr, fq, KA, 512, (pn - 2) * 256, 1.0f, 0);
        else if (pn < 6)   body<0>(acc, u, wr, wc, fr, fq, VA, 512, (pn - 4) * 256, 1.0f, 0);
        else if (pn < 8)   body<1>(acc, u, wr, wc, fr, fq, GA, 512, (pn - 6) * 256, 1.0f, 0);
        else if (pn < 10)  body<3>(acc, u, wr, wc, fr, fq, QR, 512, (pn - 8) * 256, 1.0f, 0);
        else if (pn < 12)  body<4>(acc, u, wr, wc, fr, fq, KDR, 512, (pn - 10) * 256, 1.0f, (pn - 10) * 4);
        else if (pn < 16)  body<0>(acc, u, wr, wc, fr, fq, VR, 1024, (pn - 12) * 256, 1.0f, 0);
        else if (pn < 20)  body<6>(acc, u, wr, wc, fr, fq, GR, 1024, (pn - 16) * 256, 1.0f, 0);
        else               body_gate(acc, u, wr, wc, fr, fq, pn - 20);
    }
};
struct Epi2 {
    static constexpr bool PERM = true, AFTER_DRAIN = false, CYCLIC = false; static constexpr int MID_T = 8;
    const bf16* RATIO; const bf16* SR; bf16* MIXED;
    __device__ __forceinline__ void mid(pg8::f32x4 (&acc)[2][2][4][2], const pg8::Unit& u, int wr, int wc, int fr, int fq) const {
        int fr_ = fr, fq_ = fq; asm volatile("" : "+v"(fr_), "+v"(fq_));
        const int row0 = u.pm * 256 + wr * 64 + fr_, col0 = u.pn * 256 + wc * 32 + 8 * fq_;
#pragma unroll
        for (int ai = 0; ai < 2; ++ai) {
            pg8::u32x4 s[4][2];
#pragma unroll
            for (int m = 0; m < 4; ++m)
#pragma unroll
                for (int bj = 0; bj < 2; ++bj) s[m][bj] = *(const pg8::u32x4*)(RATIO + (size_t)(row0 + ai * 128 + m * 16) * 1024 + col0 + bj * 128);
#pragma unroll
            for (int m = 0; m < 4; ++m)
#pragma unroll
                for (int bj = 0; bj < 2; ++bj) { const pg8::u32x4 q = s[m][bj]; pg8::f32x4& v0 = acc[ai][bj][m][0]; pg8::f32x4& v1 = acc[ai][bj][m][1];
                    v0[0] *= pg8::bf_lo(q.x); v0[1] *= pg8::bf_hi(q.x); v0[2] *= pg8::bf_lo(q.y); v0[3] *= pg8::bf_hi(q.y);
                    v1[0] *= pg8::bf_lo(q.z); v1[1] *= pg8::bf_hi(q.z); v1[2] *= pg8::bf_lo(q.w); v1[3] *= pg8::bf_hi(q.w); }
            __builtin_amdgcn_sched_barrier(0);
        }
    }
    __device__ __forceinline__ void operator()(pg8::f32x4 (&acc)[2][2][4][2], const pg8::Unit& u, int wr, int wc, int fr, int fq) const {
        int fr_ = fr, fq_ = fq; asm volatile("" : "+v"(fr_), "+v"(fq_));
        const int row0 = u.pm * 256 + wr * 64 + fr_, col0 = u.pn * 256 + wc * 32 + 8 * fq_;
#pragma unroll
        for (int ai = 0; ai < 2; ++ai) {
            pg8::u32x4 s[4][2];
#pragma unroll
            for (int m = 0; m < 4; ++m)
#pragma unroll
                for (int bj = 0; bj < 2; ++bj) s[m][bj] = *(const pg8::u32x4*)(SR + (size_t)(row0 + ai * 128 + m * 16) * 1024 + col0 + bj * 128);
#pragma unroll
            for (int m = 0; m < 4; ++m)
#pragma unroll
                for (int bj = 0; bj < 2; ++bj) { const pg8::u32x4 q = s[m][bj]; const pg8::f32x4 v0 = acc[ai][bj][m][0], v1 = acc[ai][bj][m][1];
                    pg8::u32x4 w; w.x = pg8::cvt_pk_bf16(v0[0] * pg8::bf_lo(q.x), v0[1] * pg8::bf_hi(q.x)); w.y = pg8::cvt_pk_bf16(v0[2] * pg8::bf_lo(q.y), v0[3] * pg8::bf_hi(q.y));
                    w.z = pg8::cvt_pk_bf16(v1[0] * pg8::bf_lo(q.z), v1[1] * pg8::bf_hi(q.z)); w.w = pg8::cvt_pk_bf16(v1[2] * pg8::bf_lo(q.w), v1[3] * pg8::bf_hi(q.w));
                    *(pg8::u32x4*)(MIXED + (size_t)(row0 + ai * 128 + m * 16) * 1024 + col0 + bj * 128) = w; }
            __builtin_amdgcn_sched_barrier(0);
        }
    }
};
struct Epi3n {
    static constexpr bool PERM = false, AFTER_DRAIN = false, CYCLIC = true; static constexpr int MID_T = 0;
    const float* X; float* OUT; const float* gain; float* xbuf; unsigned* cnt; LAS unsigned char* lds;
    __device__ __forceinline__ void operator()(pg8::f32x4 (&acc)[2][2][4][2], const pg8::Unit& u, int wr, int wc, int fr, int fq) const {
        int fr_ = fr, fq_ = fq; asm volatile("" : "+v"(fr_), "+v"(fq_));
        const int row0 = u.pm * 256 + wr * 64 + fr_, col0 = u.pn * 256 + wc * 32 + 4 * fq_;
        LAS float* P = (LAS float*)(lds + XCH_OFF); LAS float* S = P + 1024; volatile LAS unsigned* flag = (volatile LAS unsigned*)(S + 256);
        const int wid = wr * 4 + wc, lane = fq_ * 16 + fr_;
#pragma unroll
        for (int ai = 0; ai < 2; ++ai)
#pragma unroll
            for (int mp = 0; mp < 2; ++mp) {
                pg8::f32x4 xv[2][2][2];
#pragma unroll
                for (int mm = 0; mm < 2; ++mm)
#pragma unroll
                    for (int bj = 0; bj < 2; ++bj)
#pragma unroll
                        for (int n = 0; n < 2; ++n) xv[mm][bj][n] = *(const pg8::f32x4*)(X + (size_t)(row0 + ai * 128 + (2 * mp + mm) * 16) * 1024 + col0 + bj * 128 + n * 16);
#pragma unroll
                for (int mm = 0; mm < 2; ++mm) {
                    const int m = 2 * mp + mm; float s = 0.f;
#pragma unroll
                    for (int bj = 0; bj < 2; ++bj)
#pragma unroll
                        for (int n = 0; n < 2; ++n) { const pg8::f32x4 y = xv[mm][bj][n] + acc[ai][bj][m][n]; acc[ai][bj][m][n] = y; s += (y[0] * y[0] + y[1] * y[1]) + (y[2] * y[2] + y[3] * y[3]); }
                    s += __shfl_xor(s, 16); s += __shfl_xor(s, 32);
                    if (fq_ == 0) P[(ai * 128 + wr * 64 + m * 16 + fr_) * 4 + wc] = s;
                }
                __builtin_amdgcn_sched_barrier(0);
            }
        asm volatile("s_waitcnt lgkmcnt(0)\n\ts_barrier" ::: "memory");
        const int prow = wid * 32 + (lane & 31);
        if (lane < 32) {
            const float t = (P[prow * 4 + 0] + P[prow * 4 + 1]) + (P[prow * 4 + 2] + P[prow * 4 + 3]);
            __hip_atomic_store(xbuf + ((size_t)u.pm * 256 + prow) * 4 + u.pn, t, __ATOMIC_RELAXED, __HIP_MEMORY_SCOPE_AGENT);
        }
        asm volatile("s_waitcnt vmcnt(0)" ::: "memory");
        if (lane == 0) __hip_atomic_fetch_add(cnt + 64 * u.pm, 1u, __ATOMIC_RELAXED, __HIP_MEMORY_SCOPE_AGENT);
        if (wid == 0) {
            unsigned spins = 0;
            while ((unsigned)__builtin_amdgcn_readfirstlane(__hip_atomic_load(cnt + 64 * u.pm, __ATOMIC_RELAXED, __HIP_MEMORY_SCOPE_AGENT)) < 32u) { __builtin_amdgcn_s_sleep(2); if (++spins > (1u << 22)) break; }
            __builtin_amdgcn_fence(__ATOMIC_ACQUIRE, "agent");
            if (lane == 0) flag[0] = 1u;
        }
        asm volatile("s_waitcnt vmcnt(0) lgkmcnt(0)\n\ts_barrier" ::: "memory");
        if (lane < 32) {
            const float* sl = xbuf + ((size_t)u.pm * 256 + prow) * 4;
            const float ss = (__hip_atomic_load(sl + 0, __ATOMIC_RELAXED, __HIP_MEMORY_SCOPE_AGENT) + __hip_atomic_load(sl + 1, __ATOMIC_RELAXED, __HIP_MEMORY_SCOPE_AGENT)) +
                             (__hip_atomic_load(sl + 2, __ATOMIC_RELAXED, __HIP_MEMORY_SCOPE_AGENT) + __hip_atomic_load(sl + 3, __ATOMIC_RELAXED, __HIP_MEMORY_SCOPE_AGENT));
            S[prow] = 1.0f / sqrtf(ss * (1.f / 1024.f) + 1e-6f);
        }
        asm volatile("s_waitcnt vmcnt(0) lgkmcnt(0)\n\ts_barrier" ::: "memory");
        pg8::f32x4 gv[2][2];
#pragma unroll
        for (int bj = 0; bj < 2; ++bj)
#pragma unroll
            for (int n = 0; n < 2; ++n) gv[bj][n] = *(const pg8::f32x4*)(gain + col0 + bj * 128 + n * 16);
#pragma unroll
        for (int ai = 0; ai < 2; ++ai)
#pragma unroll
            for (int m = 0; m < 4; ++m) {
                const float rr = S[ai * 128 + wr * 64 + m * 16 + fr_];
#pragma unroll
                for (int bj = 0; bj < 2; ++bj)
#pragma unroll
                    for (int n = 0; n < 2; ++n) *(pg8::f32x4*)(OUT + (size_t)(row0 + ai * 128 + m * 16) * 1024 + col0 + bj * 128 + n * 16) = acc[ai][bj][m][n] * rr * gv[bj][n];
            }
    }
};

struct Args { const float* in[9]; float* out; unsigned char* ws; int ph_lo, ph_hi; };
struct Frame {
    LAS unsigned char* lds;
    int tid, lane, wave, G;
    const float *x, *norm_gain, *w_in, *rel_bias, *gn_gain, *w_out_attn, *w_out_ret, *w_out, *final_gain;
    float* out; unsigned char* ws;
    __device__ __forceinline__ bf16* WinT() const { return (bf16*)(ws + WS_WIN); }
    __device__ __forceinline__ bf16* WcatT() const { return (bf16*)(ws + WS_WCAT); }
    __device__ __forceinline__ bf16* WoT() const { return (bf16*)(ws + WS_WO); }
    __device__ __forceinline__ bf16* H() const { return (bf16*)(ws + WS_H); }
    __device__ __forceinline__ bf16* ST() const { return (bf16*)(ws + WS_ST); }
    __device__ __forceinline__ bf16* QA() const { return (bf16*)((unsigned char*)out + 0 * MiB); }
    __device__ __forceinline__ bf16* KA() const { return (bf16*)((unsigned char*)out + 64 * MiB); }
    __device__ __forceinline__ bf16* VA() const { return (bf16*)((unsigned char*)out + 128 * MiB); }
    __device__ __forceinline__ bf16* GA() const { return (bf16*)((unsigned char*)out + 192 * MiB); }
    __device__ __forceinline__ bf16* QR() const { return (bf16*)(ws + WS_QR); }
    __device__ __forceinline__ bf16* KDR() const { return (bf16*)(ws + WS_KDR); }
    __device__ __forceinline__ bf16* VR() const { return (bf16*)(ws + WS_VR); }
    __device__ __forceinline__ bf16* GR() const { return (bf16*)(ws + WS_GR); }
    __device__ __forceinline__ bf16* SA() const { return (bf16*)((unsigned char*)out + 0 * MiB); }
    __device__ __forceinline__ bf16* SR() const { return (bf16*)((unsigned char*)out + 128 * MiB); }
    __device__ __forceinline__ bf16* ACAT() const { return (bf16*)(ws + WS_ACAT); }
    __device__ __forceinline__ bf16* MIXED() const { return (bf16*)(ws + WS_MIXED); }
    __device__ __forceinline__ float* TMP() const { return (float*)(ws + WS_TMP); }
};
__device__ __forceinline__ float wave_sum(float v) {
#pragma unroll
    for (int o = 1; o < 64; o <<= 1) v += __shfl_xor(v, o);
    return v;
}

__device__ __forceinline__ int win_src_col(int c) {
    if (c >= 2048 && c < 3072) { const int p = c & 63; return (c & ~63) + ((p >> 2) & 1) * 32 + 16 * (p >> 5) + 4 * ((p >> 3) & 3) + (p & 3); }
    if (c >= 5120) { const int cc = c - 5120; return 5120 + ((cc >> 7) & 1) * 1024 + (cc >> 8) * 128 + (cc & 127); }
    return c;
}
template <bool WIN> __device__ __forceinline__ void p0_transpose_item(const float* W, int K, int N, bf16* WT, int ldo, int col_off, LAS float* scr, int item, int lane) {
    const int nblk = N / 32, kb = item / nblk, nb = item % nblk, k0 = 64 * kb, n0 = 32 * nb;
    const int sc = WIN ? win_src_col(n0 + (lane & 31)) : (n0 + (lane & 31));
#pragma unroll 8
    for (int i = 0; i < 32; ++i) { const int kk = 2 * i + (lane >> 5); scr[kk * 33 + (lane & 31)] = W[(size_t)(k0 + kk) * N + sc]; }
    asm volatile("s_waitcnt lgkmcnt(0)" ::: "memory");
    const int c = lane & 7;
#pragma unroll
    for (int j = 0; j < 4; ++j) { const int n = (lane >> 3) + 8 * j; const LAS float* s = scr + (8 * c) * 33 + n;
        u32x4 o; o.x = pk2(s[0 * 33], s[1 * 33]); o.y = pk2(s[2 * 33], s[3 * 33]); o.z = pk2(s[4 * 33], s[5 * 33]); o.w = pk2(s[6 * 33], s[7 * 33]);
        *(u32x4*)(WT + (size_t)(n0 + n) * ldo + col_off + k0 + 8 * c) = o; }
    asm volatile("s_waitcnt lgkmcnt(0)" ::: "memory");
}
__device__ __forceinline__ void p0_prologue(Frame& F) {
    LAS float* scr = (LAS float*)(F.lds + F.wave * 16384);
    const int gw = blockIdx.x * 8 + F.wave, NGW = F.G * 8;
    constexpr int I_IN = (DM / 64) * (NIN / 32), I_A = (AW / 64) * (DM / 32), I_R = (RVW / 64) * (DM / 32), I_O = (DM / 64) * (DM / 32);
    for (int it = gw; it < I_IN + I_A + I_R + I_O; it += NGW) {
        int r = it;
        if (r < I_IN) { p0_transpose_item<true>(F.w_in, DM, NIN, F.WinT(), DM, 0, scr, r, F.lane); continue; } r -= I_IN;
        if (r < I_A) { p0_transpose_item<false>(F.w_out_attn, AW, DM, F.WcatT(), KCAT, 0, scr, r, F.lane); continue; } r -= I_A;
        if (r < I_R) { p0_transpose_item<false>(F.w_out_ret, RVW, DM, F.WcatT(), KCAT, AW, scr, r, F.lane); continue; } r -= I_R;
        p0_transpose_item<false>(F.w_out, DM, DM, F.WoT(), DM, 0, scr, r, F.lane);
    }
    for (int m = gw; m < T; m += NGW) {
        const f32x4* xr = (const f32x4*)(F.x + (size_t)m * DM) + F.lane;
        const f32x4* gr = (const f32x4*)F.norm_gain + F.lane;
        f32x4 v[4]; float s = 0.f;
#pragma unroll
        for (int j = 0; j < 4; ++j) { v[j] = xr[64 * j]; s += (v[j].x * v[j].x + v[j].y * v[j].y) + (v[j].z * v[j].z + v[j].w * v[j].w); }
        const float r = 1.0f / sqrtf(wave_sum(s) * (1.f / DM) + 1e-6f);
        unsigned long long* o8 = (unsigned long long*)(F.H() + (size_t)m * DM) + F.lane;
#pragma unroll
        for (int j = 0; j < 4; ++j) { const f32x4 g = gr[64 * j]; o8[64 * j] = (unsigned long long)pk2(v[j].x * r * g.x, v[j].y * r * g.y) | ((unsigned long long)pk2(v[j].z * r * g.z, v[j].w * r * g.w) << 32); }
    }
}

__device__ __forceinline__ void load_row64(const bf16* p, float (&q)[64]) {
#pragma unroll
    for (int i = 0; i < 8; ++i) { const u32x4 w = *(const u32x4*)(p + 8 * i);
        q[8 * i + 0] = bf2f(w.x & 0xffffu); q[8 * i + 1] = bf2f(w.x >> 16); q[8 * i + 2] = bf2f(w.y & 0xffffu); q[8 * i + 3] = bf2f(w.y >> 16);
        q[8 * i + 4] = bf2f(w.z & 0xffffu); q[8 * i + 5] = bf2f(w.z >> 16); q[8 * i + 6] = bf2f(w.w & 0xffffu); q[8 * i + 7] = bf2f(w.w >> 16); }
}
#define UNPK8(V_, e) const float e##0 = bf2f((V_)[0] & 0xffffu), e##1 = bf2f((V_)[0] >> 16), e##2 = bf2f((V_)[1] & 0xffffu), e##3 = bf2f((V_)[1] >> 16), e##4 = bf2f((V_)[2] & 0xffffu), e##5 = bf2f((V_)[2] >> 16), e##6 = bf2f((V_)[3] & 0xffffu), e##7 = bf2f((V_)[3] >> 16)
__device__ __forceinline__ float dot_row64(const float (&q)[64], const bf16* p) {
    float s = 0.f;
#pragma unroll
    for (int i = 0; i < 8; ++i) { const u32x4 w = *(const u32x4*)(p + 8 * i); UNPK8(w, k);
        s += q[8 * i] * k0 + q[8 * i + 1] * k1 + q[8 * i + 2] * k2 + q[8 * i + 3] * k3 + q[8 * i + 4] * k4 + q[8 * i + 5] * k5 + q[8 * i + 6] * k6 + q[8 * i + 7] * k7; }
    return s;
}
__device__ __forceinline__ void p2_attn_ref(Frame& F) {
    const int gw = blockIdx.x * 8 + F.wave, NGW = F.G * 8, lane = F.lane;
    for (int it = gw; it < BATCH * NCH * 8; it += NGW) {
        const int h = it & 7, n = (it >> 3) & (NCH - 1), b = it >> 10;
        const size_t t = (size_t)b * SEQ + n * 64 + lane;
        float q[64], o[64]; load_row64(F.QA() + t * AW + h * 64, q);
#pragma unroll
        for (int d = 0; d < 64; ++d) o[d] = 0.f;
        float mrun = -1e30f, l = 0.f;
        const int p0 = (n >= 8) ? 0 : (8 - n) * 64;
        const float* bias = F.rel_bias + h * 257;
        for (int p = p0; p < 576; ++p) {
            const size_t tk = (size_t)b * SEQ + (n - 8) * 64 + p;
            float s = dot_row64(q, F.KA() + tk * AW + h * 64);
            int dist = lane + 512 - p; dist = dist > 128 ? 128 : dist;
            s += bias[dist + 128] * LOG2E;
            const float mn = fmaxf(mrun, s), al = fast_exp2(mrun - mn), pp = fast_exp2(s - mn);
            mrun = mn; l = l * al + pp;
            const bf16* vp = F.VA() + tk * AW + h * 64;
#pragma unroll
            for (int i = 0; i < 8; ++i) { const u32x4 w = *(const u32x4*)(vp + 8 * i); UNPK8(w, v);
                o[8 * i] = o[8 * i] * al + pp * v0; o[8 * i + 1] = o[8 * i + 1] * al + pp * v1; o[8 * i + 2] = o[8 * i + 2] * al + pp * v2; o[8 * i + 3] = o[8 * i + 3] * al + pp * v3;
                o[8 * i + 4] = o[8 * i + 4] * al + pp * v4; o[8 * i + 5] = o[8 * i + 5] * al + pp * v5; o[8 * i + 6] = o[8 * i + 6] * al + pp * v6; o[8 * i + 7] = o[8 * i + 7] * al + pp * v7; }
        }
        const float rl = 1.0f / l;
        const bf16* gp = F.GA() + t * AW + h * 64;
        bf16* op = F.ACAT() + t * KCAT + h * 64;
#pragma unroll
        for (int i = 0; i < 8; ++i) { const u32x4 gw4 = *(const u32x4*)(gp + 8 * i); UNPK8(gw4, g);
            u32x4 w; w.x = pk2(o[8 * i] * rl * g0, o[8 * i + 1] * rl * g1); w.y = pk2(o[8 * i + 2] * rl * g2, o[8 * i + 3] * rl * g3);
            w.z = pk2(o[8 * i + 4] * rl * g4, o[8 * i + 5] * rl * g5); w.w = pk2(o[8 * i + 6] * rl * g6, o[8 * i + 7] * rl * g7); *(u32x4*)(op + 8 * i) = w; }
    }
}

typedef short bf16x8 __attribute__((ext_vector_type(8)));
typedef float f32x16 __attribute__((ext_vector_type(16)));
typedef short s16x4 __attribute__((ext_vector_type(4)));
typedef float f32x2_t __attribute__((ext_vector_type(2)));
typedef __bf16 bf16x2_t __attribute__((ext_vector_type(2)));
__device__ __forceinline__ unsigned cvtpk(float lo, float hi) { f32x2_t v = {lo, hi}; bf16x2_t b = __builtin_convertvector(v, bf16x2_t); return __builtin_bit_cast(unsigned, b); }
__device__ __forceinline__ s16x4 lds_tr16a(const LAS unsigned char* p) { s16x4 r; const unsigned a = (unsigned)(unsigned long long)p; asm volatile("ds_read_b64_tr_b16 %0, %1" : "=v"(r) : "v"(a) : "memory"); return r; }
__device__ __forceinline__ void dma16_asm(const void* g, unsigned lds_byte) { asm volatile("s_mov_b32 m0, %1\n\ts_nop 0\n\tglobal_load_lds_dwordx4 %0, off" :: "v"(g), "s"(lds_byte) : "memory"); }
template <int OFF> __device__ __forceinline__ s16x4 lds_tr16o(unsigned a) { s16x4 r; asm volatile("ds_read_b64_tr_b16 %0, %1 offset:%c2" : "=v"(r) : "v"(a), "i"(OFF) : "memory"); return r; }
__device__ __forceinline__ unsigned lds_off(const LAS unsigned char* p) { return (unsigned)(unsigned long long)p; }
#define TR_WAIT() do { asm volatile("s_waitcnt lgkmcnt(0)" ::: "memory"); __builtin_amdgcn_sched_barrier(0); } while (0)
__device__ __forceinline__ s16x4 lds_tr16(const LAS unsigned char* p) { return __builtin_bit_cast(s16x4, __builtin_amdgcn_ds_read_tr16_b64_v4i16((LAS s16x4*)p)); }
__device__ __forceinline__ bf16x8 pack8(const f32x16& p, int b) {
    u32x4 w; w.x = cvtpk(p[b], p[b + 1]); w.y = cvtpk(p[b + 2], p[b + 3]); w.z = cvtpk(p[b + 4], p[b + 5]); w.w = cvtpk(p[b + 6], p[b + 7]); return __builtin_bit_cast(bf16x8, w);
}
#define MFMA32(a, b, c) __builtin_amdgcn_mfma_f32_32x32x16_bf16((a), (b), (c), 0, 0, 0)
constexpr int ATT_TBL_OFF = 131072;
__device__ __forceinline__ void p5_attn_mfma(Frame& F) {
    LAS unsigned char* lds = F.lds;
    LAS float* tbl = (LAS float*)(lds + ATT_TBL_OFF);
    for (int i = F.tid; i < 8 * 257; i += 512) { const int hh = i / 257, k = i - hh * 257; tbl[hh * 260 + k] = F.rel_bias[i] * LOG2E; }
    __syncthreads();
    const int lane = F.lane, r32 = lane & 31, hi = lane >> 5, l16 = lane & 15, g16 = (lane >> 4) & 1;
    LAS unsigned char* wl = lds + F.wave * 16384;
    const int kread = r32 * 128;
    const int vsw = ((l16 >> 3) & 1) << 2, vbase = (l16 >> 2) * 128 + 8 * (l16 & 1), vc = 2 * g16 + ((l16 & 3) >> 1);
    const int drow = lane >> 3, cpos = lane & 7;
    const int ksrc = drow * AW + ((cpos ^ drow) << 3);
    const int vsrc = drow * AW + ((cpos ^ (((drow >> 1) & 1) << 2)) << 3);
    for (int gi = blockIdx.x; gi < BATCH * 8 * 16; gi += F.G) {
        const int g = (F.G == 256) ? ((gi & 7) * 32 + ((gi >> 3) & 31) + (gi & ~255)) : gi;
        const int h = (g >> 4) & 7, n = (g & 15) * 8 + F.wave, b = g >> 7;
        __builtin_amdgcn_s_barrier();
        const long tq0 = (long)b * SEQ + n * 64, tk0 = tq0 - 512;
        const LAS float* tblh = tbl + h * 260;
        const float cb = tblh[256];
        bf16x8 qf[2][4];
#pragma unroll
        for (int qb = 0; qb < 2; ++qb)
#pragma unroll
            for (int s = 0; s < 4; ++s) qf[qb][s] = *(const bf16x8*)(F.QA() + (tq0 + 32 * qb + r32) * AW + h * 64 + 16 * s + 8 * hi);
        f32x16 ot[2][2];
#pragma unroll
        for (int a = 0; a < 2; ++a)
#pragma unroll
            for (int c = 0; c < 2; ++c)
#pragma unroll
                for (int r = 0; r < 16; ++r) ot[a][c][r] = 0.f;
        float mrun[2] = {-1e30f, -1e30f}, lsum[2] = {0.f, 0.f};
        const int jt0 = (n >= 8) ? 0 : 2 * (8 - n);
        const bf16* kg = F.KA() + tk0 * AW + h * 64; const bf16* vg = F.VA() + tk0 * AW + h * 64;
#define ATT_ISSUE(jt_, sl_) do { LAS unsigned char* d_ = wl + (sl_) * 8192; const long ro_ = (long)(jt_) * 32 * AW; \
        _Pragma("unroll") for (int ii = 0; ii < 4; ++ii) __builtin_amdgcn_global_load_lds((const unsigned*)(kg + ro_ + ii * 8 * AW + ksrc), (LAS unsigned*)(d_ + ii * 1024), 16, 0, 0); \
        _Pragma("unroll") for (int ii = 0; ii < 4; ++ii) __builtin_amdgcn_global_load_lds((const unsigned*)(vg + ro_ + ii * 8 * AW + vsrc), (LAS unsigned*)(d_ + 4096 + ii * 1024), 16, 0, 0); } while (0)
        int jt = (n >= 8) ? 2 * ((143 - n) % 9) : jt0;
        const int ntl = 18 - jt0;
        ATT_ISSUE(jt, 0);
        for (int i = 0; i < ntl; ++i) {
            const int sl = i & 1;
            const int jn = (jt + 1 == 18) ? jt0 : jt + 1;
            if (i + 1 < ntl) { ATT_ISSUE(jn, sl ^ 1); asm volatile("s_waitcnt vmcnt(8)" ::: "memory"); }
            else asm volatile("s_waitcnt vmcnt(0)" ::: "memory");
            const LAS unsigned char* ks = wl + sl * 8192; const LAS unsigned char* vs = ks + 4096;
            bf16x8 kf[4];
#pragma unroll
            for (int s = 0; s < 4; ++s) kf[s] = *(const LAS bf16x8*)(ks + kread + (((2 * s + hi) ^ (r32 & 7)) << 4));
            f32x16 sa[2];
#pragma unroll
            for (int qb = 0; qb < 2; ++qb)
#pragma unroll
                for (int r = 0; r < 16; ++r) sa[qb][r] = 0.f;
#pragma unroll
            for (int s = 0; s < 4; ++s) { sa[0] = MFMA32(kf[s], qf[0][s], sa[0]); sa[1] = MFMA32(kf[s], qf[1][s], sa[1]); }
            float bc = cb;
            if (jt >= 12) {
                bc = 0.f;
#pragma unroll
                for (int qb = 0; qb < 2; ++qb)
#pragma unroll
                    for (int r = 0; r < 16; ++r) { int dist = 32 * qb + r32 + 512 - 32 * jt - ((r & 3) + 8 * (r >> 2) + 4 * hi); dist = dist > 128 ? 128 : dist; sa[qb][r] += tblh[dist + 128]; }
            }
            s16x4 vlo[2][2], vhi[2][2];
#pragma unroll
            for (int db = 0; db < 2; ++db)
                { const unsigned vb_ = lds_off(vs) + 4 * hi * 128 + vbase + (((4 * db + vc) ^ vsw) << 4);
                  vlo[db][0] = lds_tr16o<0>(vb_); vhi[db][0] = lds_tr16o<1024>(vb_); vlo[db][1] = lds_tr16o<2048>(vb_); vhi[db][1] = lds_tr16o<3072>(vb_); }
            bf16x8 pp[2][2];
#pragma unroll
            for (int qb = 0; qb < 2; ++qb) {
                float mx = sa[qb][0];
#pragma unroll
                for (int r = 1; r < 16; ++r) mx = fmaxf(mx, sa[qb][r]);
                mx = fmaxf(mx, __shfl_xor(mx, 32)) + bc;
                const float mn = fmaxf(mrun[qb], mx), al = fast_exp2(mrun[qb] - mn);
                mrun[qb] = mn;
                const float mo = mn - bc;
                float ps = 0.f;
#pragma unroll
                for (int r = 0; r < 16; ++r) { const float pv = fast_exp2(sa[qb][r] - mo); sa[qb][r] = pv; ps += pv; }
                lsum[qb] = lsum[qb] * al + ps;
#pragma unroll
                for (int r = 0; r < 16; ++r) { ot[0][qb][r] *= al; ot[1][qb][r] *= al; }
                pp[qb][0] = pack8(sa[qb], 0); pp[qb][1] = pack8(sa[qb], 8);
            }
            TR_WAIT();
#pragma unroll
            for (int db = 0; db < 2; ++db)
#pragma unroll
                for (int s2 = 0; s2 < 2; ++s2) {
                    const bf16x8 vf = {vlo[db][s2][0], vlo[db][s2][1], vlo[db][s2][2], vlo[db][s2][3], vhi[db][s2][0], vhi[db][s2][1], vhi[db][s2][2], vhi[db][s2][3]};
                    ot[db][0] = MFMA32(vf, pp[0][s2], ot[db][0]); ot[db][1] = MFMA32(vf, pp[1][s2], ot[db][1]);
                }
            jt = jn;
        }
#undef ATT_ISSUE
#pragma unroll
        for (int qb = 0; qb < 2; ++qb) {
            const float lt = lsum[qb] + __shfl_xor(lsum[qb], 32), inv = 1.0f / lt;
            const long t = tq0 + 32 * qb + r32;
#pragma unroll
            for (int db = 0; db < 2; ++db)
#pragma unroll
                for (int gp = 0; gp < 2; ++gp) {
                    const int d0 = 32 * db + 16 * gp + 8 * hi;
                    const u32x4 q4 = *(const u32x4*)(F.GA() + t * AW + h * 64 + d0);
                    const auto a0 = __builtin_amdgcn_permlane32_swap(q4.x, q4.z, false, false), a1 = __builtin_amdgcn_permlane32_swap(q4.y, q4.w, false, false);
                    u32x2 w[2];
#pragma unroll
                    for (int e = 0; e < 2; ++e) { const int g = 2 * gp + e; const unsigned gx = a0[e], gy = a1[e];
                        w[e].x = cvtpk(ot[db][qb][4 * g] * inv * bf2f(gx & 0xffffu), ot[db][qb][4 * g + 1] * inv * bf2f(gx >> 16));
                        w[e].y = cvtpk(ot[db][qb][4 * g + 2] * inv * bf2f(gy & 0xffffu), ot[db][qb][4 * g + 3] * inv * bf2f(gy >> 16)); }
                    const auto s0 = __builtin_amdgcn_permlane32_swap(w[0].x, w[1].x, false, false), s1 = __builtin_amdgcn_permlane32_swap(w[0].y, w[1].y, false, false);
                    const u32x4 w4 = {s0[0], s1[0], s0[1], s1[1]};
                    *(u32x4*)(F.ACAT() + t * KCAT + h * 64 + d0) = w4;
                }
        }
    }
}


constexpr int SC_S0_OFF = 131072;
__device__ __forceinline__ void p2_scan_mfma(Frame& F) {
    const int lane = F.lane, r32 = lane & 31, hi = lane >> 5, l16 = lane & 15, g16 = (lane >> 4) & 1, w = F.wave;
    LAS unsigned char* reg = F.lds + w * 16384;
    const int xq = l16 >> 2, x1 = (l16 & 3) >> 1, x0 = l16 & 1;
    const int ka_off = (8 * hi + xq) * 128 + 8 * x0, ka_sw = ((l16 >> 3) & 1) << 2, ka_c = 2 * g16 + x1;
    const int vb_off = (8 * hi + xq) * 64 + ((2 * g16 + x1) << 4) + 8 * x0;
    const int kdrow = lane >> 3, kc16 = (lane & 7) ^ ((((lane >> 3) >> 1) & 1) << 2);
    const int vdrow = lane >> 2, vc16 = lane & 3;
    for (int unit = blockIdx.x; unit < BATCH * 8 * 4; unit += F.G) {
        const int i = unit & 3, h = (unit >> 2) & 7, b = unit >> 5;
        const float g64 = fast_exp2(64.0f * log2gamma(h));
        const bf16* kg = F.KDR() + ((long)b * SEQ + kdrow) * RQK + h * 64 + kc16 * 8;
        const bf16* vg = F.VR() + ((long)b * SEQ + vdrow) * RVW + h * 128 + 32 * i + vc16 * 8;
        bf16* stg = F.ST() + (long)(b * 8 + h) * NCH * 8192 + i * 2048 + lane * 8;
#define SC_ISSUE(n_) do { const long ro_ = (long)(n_) * 64; \
        _Pragma("unroll") for (int ii = 0; ii < 8; ++ii) __builtin_amdgcn_global_load_lds((const unsigned*)(kg + (ro_ + 8 * ii) * RQK), (LAS unsigned*)(reg + ii * 1024), 16, 0, 0); \
        _Pragma("unroll") for (int ii = 0; ii < 4; ++ii) __builtin_amdgcn_global_load_lds((const unsigned*)(vg + (ro_ + 16 * ii) * RVW), (LAS unsigned*)(reg + 8192 + ii * 1024), 16, 0, 0); } while (0)
        { LAS f32x4* z = (LAS f32x4*)(F.lds + SC_S0_OFF); for (int k = F.tid; k < 512; k += 512) z[k] = (f32x4){0.f, 0.f, 0.f, 0.f}; }
        SC_ISSUE(w);
        for (int r = 0; r < 12; ++r) {
            const int n = 8 * r + w;
            asm volatile("s_waitcnt vmcnt(0)" ::: "memory");
            s16x4 bl[4], bh[4], al[2][4], ah[2][4];
            { const unsigned vb_ = lds_off(reg) + 8192 + vb_off;
              bl[0] = lds_tr16o<0>(vb_); bh[0] = lds_tr16o<256>(vb_); bl[1] = lds_tr16o<1024>(vb_); bh[1] = lds_tr16o<1280>(vb_);
              bl[2] = lds_tr16o<2048>(vb_); bh[2] = lds_tr16o<2304>(vb_); bl[3] = lds_tr16o<3072>(vb_); bh[3] = lds_tr16o<3328>(vb_); }
#pragma unroll
            for (int jb = 0; jb < 2; ++jb) { const unsigned kb_ = lds_off(reg) + ka_off + (((4 * jb + ka_c) ^ ka_sw) << 4);
              al[jb][0] = lds_tr16o<0>(kb_); ah[jb][0] = lds_tr16o<512>(kb_); al[jb][1] = lds_tr16o<2048>(kb_); ah[jb][1] = lds_tr16o<2560>(kb_);
              al[jb][2] = lds_tr16o<4096>(kb_); ah[jb][2] = lds_tr16o<4608>(kb_); al[jb][3] = lds_tr16o<6144>(kb_); ah[jb][3] = lds_tr16o<6656>(kb_); }
            TR_WAIT();
            if (r < 11) SC_ISSUE(n + 8);
            f32x16 kv[2];
#pragma unroll
            for (int rr = 0; rr < 16; ++rr) { kv[0][rr] = 0.f; kv[1][rr] = 0.f; }
#pragma unroll
            for (int s = 0; s < 4; ++s) {
                const bf16x8 bfr = {bl[s][0], bl[s][1], bl[s][2], bl[s][3], bh[s][0], bh[s][1], bh[s][2], bh[s][3]};
#pragma unroll
                for (int jb = 0; jb < 2; ++jb) {
                    const bf16x8 afr = {al[jb][s][0], al[jb][s][1], al[jb][s][2], al[jb][s][3], ah[jb][s][0], ah[jb][s][1], ah[jb][s][2], ah[jb][s][3]};
                    kv[jb] = MFMA32(afr, bfr, kv[jb]);
                }
            }
            { LAS u32x4* kq = (LAS u32x4*)(reg + 12288 + 64 * lane);
#pragma unroll
              for (int jb = 0; jb < 2; ++jb) { kq[2 * jb] = __builtin_bit_cast(u32x4, pack8(kv[jb], 0)); kq[2 * jb + 1] = __builtin_bit_cast(u32x4, pack8(kv[jb], 8)); } }
            asm volatile("s_waitcnt lgkmcnt(0)\n\ts_barrier" ::: "memory");
            f32x16 S[2];
            { const LAS f32x4* s0 = (const LAS f32x4*)(F.lds + SC_S0_OFF + (r & 1) * 8192 + 128 * lane);
#pragma unroll
              for (int jb = 0; jb < 2; ++jb)
#pragma unroll
                  for (int q4 = 0; q4 < 4; ++q4) { const f32x4 v = s0[4 * jb + q4]; S[jb][4 * q4] = v[0]; S[jb][4 * q4 + 1] = v[1]; S[jb][4 * q4 + 2] = v[2]; S[jb][4 * q4 + 3] = v[3]; } }
            for (int j = 0; j < w; ++j) {
                const LAS u32x4* kq = (const LAS u32x4*)(F.lds + j * 16384 + 12288 + 64 * lane);
#pragma unroll
                for (int jb = 0; jb < 2; ++jb)
#pragma unroll
                    for (int hq = 0; hq < 2; ++hq) { const u32x4 v = kq[2 * jb + hq];
                        S[jb][8 * hq + 0] = S[jb][8 * hq + 0] * g64 + bf2f(v.x & 0xffffu); S[jb][8 * hq + 1] = S[jb][8 * hq + 1] * g64 + bf2f(v.x >> 16);
                        S[jb][8 * hq + 2] = S[jb][8 * hq + 2] * g64 + bf2f(v.y & 0xffffu); S[jb][8 * hq + 3] = S[jb][8 * hq + 3] * g64 + bf2f(v.y >> 16);
                        S[jb][8 * hq + 4] = S[jb][8 * hq + 4] * g64 + bf2f(v.z & 0xffffu); S[jb][8 * hq + 5] = S[jb][8 * hq + 5] * g64 + bf2f(v.z >> 16);
                        S[jb][8 * hq + 6] = S[jb][8 * hq + 6] * g64 + bf2f(v.w & 0xffffu); S[jb][8 * hq + 7] = S[jb][8 * hq + 7] * g64 + bf2f(v.w >> 16); }
            }
#define SC_STORE(S_, n_) do { _Pragma("unroll") for (int jb = 0; jb < 2; ++jb) _Pragma("unroll") for (int gp = 0; gp < 2; ++gp) {     \
                    u32x2 wv[2]; \
                    _Pragma("unroll") for (int e = 0; e < 2; ++e) { const int g = 2 * gp + e; wv[e].x = cvtpk(S_[jb][4 * g], S_[jb][4 * g + 1]); wv[e].y = cvtpk(S_[jb][4 * g + 2], S_[jb][4 * g + 3]); } \
                    const auto s0 = __builtin_amdgcn_permlane32_swap(wv[0].x, wv[1].x, false, false), s1 = __builtin_amdgcn_permlane32_swap(wv[0].y, wv[1].y, false, false); \
                    const u32x4 w4 = {s0[0], s1[0], s0[1], s1[1]}; \
                    *(u32x4*)(stg + (long)(n_) * 8192 + (2 * jb + gp) * 512) = w4; } } while (0)
            if (w == 0 && (r == 4 || r == 8)) SC_STORE(S, n);
            if (w == 7) {
                LAS f32x4* s1 = (LAS f32x4*)(F.lds + SC_S0_OFF + ((r + 1) & 1) * 8192 + 128 * lane);
#pragma unroll
                for (int jb = 0; jb < 2; ++jb)
#pragma unroll
                    for (int q4 = 0; q4 < 4; ++q4) s1[4 * jb + q4] = (f32x4){S[jb][4 * q4] * g64 + kv[jb][4 * q4], S[jb][4 * q4 + 1] * g64 + kv[jb][4 * q4 + 1], S[jb][4 * q4 + 2] * g64 + kv[jb][4 * q4 + 2], S[jb][4 * q4 + 3] * g64 + kv[jb][4 * q4 + 3]};
            }
            asm volatile("s_waitcnt lgkmcnt(0)\n\ts_barrier" ::: "memory");
        }
        if (w == 0) {
            f32x16 S[2];
            const LAS f32x4* s0 = (const LAS f32x4*)(F.lds + SC_S0_OFF + 128 * lane);
#pragma unroll
            for (int jb = 0; jb < 2; ++jb)
#pragma unroll
                for (int q4 = 0; q4 < 4; ++q4) { const f32x4 v = s0[4 * jb + q4]; S[jb][4 * q4] = v[0]; S[jb][4 * q4 + 1] = v[1]; S[jb][4 * q4 + 2] = v[2]; S[jb][4 * q4 + 3] = v[3]; }
            SC_STORE(S, 96);
        }
        __syncthreads();
#undef SC_STORE
#undef SC_ISSUE
    }
}
__device__ __forceinline__ void p3_ret_mfma(Frame& F) {
    LAS unsigned char* vt = F.lds + F.wave * 16384;
    const int gw = blockIdx.x * 8 + F.wave, NGW = F.G * 8;
    for (int it = gw; it < BATCH * NCH * 8; it += NGW) {
        const int ln_ = lane_id_asm(); int r32 = ln_ & 31, hi = ln_ >> 5;
        const int l16 = ln_ & 15, g16 = (ln_ >> 4) & 1;
        const int vrd = (l16 >> 2) * 256 + 8 * (l16 & 1), vrsw = (l16 >> 2) << 2, vrc = 2 * g16 + ((l16 & 3) >> 1);
        const int ddrow = ln_ >> 4, dc16 = (ln_ & 15) ^ (((ln_ >> 4) & 3) << 2);
        const int h = it & 7, n = (it >> 3) & (NCH - 1), b = it >> 10;
        const long t0 = (long)b * SEQ + n * 64;
        const float l2g = log2gamma(h);
        { const bf16* vgs = F.VR() + t0 * RVW + h * 128; const unsigned vgo = (unsigned)(ddrow * RVW + dc16 * 8);
#pragma unroll
          for (int ii = 0; ii < 16; ++ii) __builtin_amdgcn_global_load_lds((const unsigned*)(vgs + ii * 4 * RVW + vgo), (LAS unsigned*)(vt + ii * 1024), 16, 0, 0); }
        int r32v = r32, hiv = hi; asm volatile("" : "+v"(r32v), "+v"(hiv));
        asm volatile("s_waitcnt vmcnt(0)" ::: "memory");
#pragma unroll 1
        for (int qb = 0; qb < 2; ++qb) {
            const bf16* stp = F.ST() + ((long)(b * 8 + h) * NCH + n) * 8192; const unsigned sto = (unsigned)((hiv * 32 + r32v) * 8);
            const long tq = t0 + 32 * qb; const unsigned rq = (unsigned)(r32 * RQK + 8 * hi), rv2 = (unsigned)(r32 * RVW + 8 * hi), ra2 = (unsigned)(r32 * KCAT + 8 * hi);
            bf16x8 qf[4], pp[4];
#pragma unroll
            for (int s = 0; s < 4; ++s) qf[s] = *(const bf16x8*)(F.QR() + tq * RQK + h * 64 + 16 * s + rq);
#pragma unroll
            for (int kb = 0; kb < 2; ++kb) {
                bf16x8 kf[4];
#pragma unroll
                for (int s = 0; s < 4; ++s) kf[s] = *(const bf16x8*)(F.KDR() + (t0 + 32 * kb) * RQK + h * 64 + 16 * s + rq);
                f32x16 sa;
#pragma unroll
                for (int r = 0; r < 16; ++r) sa[r] = 0.f;
#pragma unroll
                for (int s = 0; s < 4; ++s) sa = MFMA32(kf[s], qf[s], sa);
                __builtin_amdgcn_sched_barrier(0);
#pragma unroll
                for (int r = 0; r < 16; ++r) { const int k = 32 * kb + (r & 3) + 8 * (r >> 2) + 4 * hiv, q = 32 * qb + r32v; const int ad = q > k ? q - k : k - q;
                    sa[r] *= fast_exp2(l2g * (float)(ad - 63 + k)); }
                pp[2 * kb] = pack8(sa, 0); pp[2 * kb + 1] = pack8(sa, 8);
                __builtin_amdgcn_sched_barrier(0);
            }
            const float cr = fast_exp2(l2g * (float)(32 * qb + r32 + 1));
            f32x16 o[4];
#pragma unroll
            for (int db = 0; db < 4; ++db) {
                bf16x8 sf[4];
#pragma unroll
                for (int s = 0; s < 4; ++s) sf[s] = *(const bf16x8*)(stp + (db * 4 + s) * 512 + sto);
                s16x4 vlo[4], vhi[4];
                { const unsigned vb_ = lds_off(vt) + 4 * hi * 256 + vrd + (((4 * db + vrc) ^ vrsw) << 4);
                  vlo[0] = lds_tr16o<0>(vb_); vhi[0] = lds_tr16o<2048>(vb_); vlo[1] = lds_tr16o<4096>(vb_); vhi[1] = lds_tr16o<6144>(vb_);
                  vlo[2] = lds_tr16o<8192>(vb_); vhi[2] = lds_tr16o<10240>(vb_); vlo[3] = lds_tr16o<12288>(vb_); vhi[3] = lds_tr16o<14336>(vb_); }
#pragma unroll
                for (int r = 0; r < 16; ++r) o[db][r] = 0.f;
                TR_WAIT();
#pragma unroll
                for (int s4 = 0; s4 < 4; ++s4) {
                    const bf16x8 vf = {vlo[s4][0], vlo[s4][1], vlo[s4][2], vlo[s4][3], vhi[s4][0], vhi[s4][1], vhi[s4][2], vhi[s4][3]};
                    o[db] = MFMA32(vf, pp[s4], o[db]);
                }
                f32x16 oc;
#pragma unroll
                for (int r = 0; r < 16; ++r) oc[r] = 0.f;
#pragma unroll
                for (int s = 0; s < 4; ++s) oc = MFMA32(sf[s], qf[s], oc);
#pragma unroll
                for (int r = 0; r < 16; ++r) o[db][r] += cr * oc[r];
                __builtin_amdgcn_sched_barrier(0);
            }
            u32x2 gv[4][4];
#pragma unroll
            for (int db = 0; db < 4; ++db)
#pragma unroll
                for (int gp = 0; gp < 2; ++gp) {
                    const u32x4 q4 = *(const u32x4*)(F.GR() + tq * RVW + h * 128 + 32 * db + 16 * gp + rv2);
                    const auto s0 = __builtin_amdgcn_permlane32_swap(q4.x, q4.z, false, false), s1 = __builtin_amdgcn_permlane32_swap(q4.y, q4.w, false, false);
                    gv[db][2 * gp].x = s0[0]; gv[db][2 * gp].y = s1[0]; gv[db][2 * gp + 1].x = s0[1]; gv[db][2 * gp + 1].y = s1[1];
                }
            float sum = 0.f;
#pragma unroll
            for (int db = 0; db < 4; ++db)
#pragma unroll
                for (int r = 0; r < 16; ++r) sum += o[db][r];
            sum += __shfl_xor(sum, 32);
            const float mean = sum * (1.f / 128.f);
            float sq = 0.f;
#pragma unroll
            for (int db = 0; db < 4; ++db)
#pragma unroll
                for (int r = 0; r < 16; ++r) { const float d = o[db][r] - mean; sq += d * d; }
            sq += __shfl_xor(sq, 32);
            const float rstd = 1.0f / sqrtf(sq * (1.f / 128.f) + 1e-5f);
#pragma unroll
            for (int db = 0; db < 4; ++db)
#pragma unroll
                for (int gp = 0; gp < 2; ++gp) {
                    u32x2 w[2];
#pragma unroll
                    for (int e = 0; e < 2; ++e) { const int g = 2 * gp + e; const u32x2 q2 = gv[db][g];
                        w[e].x = cvtpk((o[db][4 * g] - mean) * rstd * bf2f(q2.x & 0xffffu), (o[db][4 * g + 1] - mean) * rstd * bf2f(q2.x >> 16));
                        w[e].y = cvtpk((o[db][4 * g + 2] - mean) * rstd * bf2f(q2.y & 0xffffu), (o[db][4 * g + 3] - mean) * rstd * bf2f(q2.y >> 16)); }
                    const auto s0 = __builtin_amdgcn_permlane32_swap(w[0].x, w[1].x, false, false), s1 = __builtin_amdgcn_permlane32_swap(w[0].y, w[1].y, false, false);
                    const u32x4 w4 = {s0[0], s1[0], s0[1], s1[1]};
                    *(u32x4*)(F.ACAT() + tq * KCAT + AW + h * 128 + 32 * db + 16 * gp + ra2) = w4;
                }
        }
    }
}

constexpr int R1_BUF = 49152;
__device__ __forceinline__ void p2_seg_state(Frame& F) {
    LAS unsigned char* lds = F.lds;
    const int w = F.wave, db = w & 3, th = w >> 2;
    const unsigned lds_base = (unsigned)__builtin_amdgcn_readfirstlane((int)lds_off(lds));
    for (int u0 = blockIdx.x; u0 < BATCH * 8 * 4; u0 += F.G) {
        const int u = (F.G == 256) ? ((u0 & 7) * 32 + (u0 >> 3)) : u0;
        const int seg = u & 3, h = (u >> 2) & 7, b = u >> 5, n0 = seg * 32;
        if (seg == 3) continue;
        const int ln = lane_id_asm(), hi = ln >> 5, l16 = ln & 15, g16 = (ln >> 4) & 1;
        const float l2g = log2gamma(h), g128 = fast_exp2(128.0f * l2g);
        const int drow = ln >> 3;
        const unsigned kt_src = (unsigned)(drow * RQK + (((ln & 7) ^ (((drow >> 1) & 1) << 2)) << 3));
        const unsigned v_src = (unsigned)((ln >> 4) * RVW + (((ln & 15) ^ (((ln >> 4) & 3) << 2)) << 3));
        const long tb = (long)b * SEQ + n0 * 64;
        const bf16* kg = F.KDR() + tb * RQK + h * 64; const bf16* vg = F.VR() + tb * RVW + h * 128;
#define R1_ISSUE(j_) do { _Pragma("unroll") for (int c_ = 0; c_ < 2; ++c_) { const unsigned bo_ = lds_base + ((j_) & 1) * R1_BUF + c_ * 24576 + w * 1024; const long ro_ = (long)(2 * (j_) + c_) * 64; \
        dma16_asm(kg + (ro_ + 8 * w) * RQK + kt_src, bo_); dma16_asm(vg + (ro_ + 4 * w) * RVW + v_src, bo_ + 8192); dma16_asm(vg + (ro_ + 32 + 4 * w) * RVW + v_src, bo_ + 8192 + 8192); } } while (0)
        R1_ISSUE(0);
        f32x16 acc[2];
#pragma unroll
        for (int r = 0; r < 16; ++r) { acc[0][r] = 0.f; acc[1][r] = 0.f; }
        const int xq = l16 >> 2, x1 = (l16 & 3) >> 1, x0 = l16 & 1;
        const unsigned ka_off = (unsigned)((4 * hi + xq) * 128 + 8 * x0), ka_sw = (unsigned)(((l16 >> 3) & 1) << 2), ka_c = (unsigned)(2 * g16 + x1);
        const unsigned vrd = (unsigned)((l16 >> 2) * 256 + 8 * (l16 & 1)), vrsw = (unsigned)((l16 >> 2) << 2), vrc = (unsigned)(2 * g16 + ((l16 & 3) >> 1));
#pragma unroll 1
        for (int j = 0; j < 16; ++j) {
            asm volatile("s_waitcnt vmcnt(0)\n\ts_barrier" ::: "memory");
            if (j + 1 < 16) R1_ISSUE(j + 1);
            LAS unsigned char* bufp = lds + (j & 1) * R1_BUF + th * 24576;
            s16x4 vlo[4], vhi[4], al[2][4], ah[2][4];
            { const unsigned vb_ = lds_off(bufp) + 8192 + 4 * hi * 256 + vrd + (((4 * db + vrc) ^ vrsw) << 4);
              vlo[0] = lds_tr16o<0>(vb_); vhi[0] = lds_tr16o<2048>(vb_); vlo[1] = lds_tr16o<4096>(vb_); vhi[1] = lds_tr16o<6144>(vb_);
              vlo[2] = lds_tr16o<8192>(vb_); vhi[2] = lds_tr16o<10240>(vb_); vlo[3] = lds_tr16o<12288>(vb_); vhi[3] = lds_tr16o<14336>(vb_); }
#pragma unroll
            for (int jb = 0; jb < 2; ++jb) { const unsigned kb_ = lds_off(bufp) + ka_off + (((4 * jb + ka_c) ^ ka_sw) << 4);
              al[jb][0] = lds_tr16o<0>(kb_); ah[jb][0] = lds_tr16o<1024>(kb_); al[jb][1] = lds_tr16o<2048>(kb_); ah[jb][1] = lds_tr16o<3072>(kb_);
              al[jb][2] = lds_tr16o<4096>(kb_); ah[jb][2] = lds_tr16o<5120>(kb_); al[jb][3] = lds_tr16o<6144>(kb_); ah[jb][3] = lds_tr16o<7168>(kb_); }
#pragma unroll
            for (int r = 0; r < 16; ++r) { acc[0][r] *= g128; acc[1][r] *= g128; }
            TR_WAIT();
#pragma unroll
            for (int s4 = 0; s4 < 4; ++s4) {
                const bf16x8 vf = {vlo[s4][0], vlo[s4][1], vlo[s4][2], vlo[s4][3], vhi[s4][0], vhi[s4][1], vhi[s4][2], vhi[s4][3]};
#pragma unroll
                for (int jb = 0; jb < 2; ++jb) {
                    const bf16x8 afr = {al[jb][s4][0], al[jb][s4][1], al[jb][s4][2], al[jb][s4][3], ah[jb][s4][0], ah[jb][s4][1], ah[jb][s4][2], ah[jb][s4][3]};
                    acc[jb] = MFMA32(afr, vf, acc[jb]);
                }
            }
        }
#undef R1_ISSUE
        { f32x4* eg = (f32x4*)F.ST() + ((long)((u * 2 + th) * 4 + db) * 8) * 64 + ln;
#pragma unroll
          for (int jb = 0; jb < 2; ++jb)
#pragma unroll
              for (int q4 = 0; q4 < 4; ++q4) eg[(4 * jb + q4) * 64] = (f32x4){acc[jb][4 * q4], acc[jb][4 * q4 + 1], acc[jb][4 * q4 + 2], acc[jb][4 * q4 + 3]}; }
        __syncthreads();
    }
}
constexpr int R2_BUF = 40960;
constexpr int R2_STAT = 2 * R2_BUF;
__device__ __forceinline__ void p3_ret2(Frame& F) {
    LAS unsigned char* lds = F.lds;
    const int w = F.wave, db = w & 3, th = w >> 2;
    const unsigned lds_base = (unsigned)__builtin_amdgcn_readfirstlane((int)lds_off(lds));
    for (int u0 = blockIdx.x; u0 < BATCH * 8 * 4; u0 += F.G) {
        const int u = (F.G == 256) ? ((u0 & 7) * 32 + (u0 >> 3)) : u0;
        const int ln = lane_id_asm(), r32 = ln & 31, hi = ln >> 5, l16 = ln & 15, g16 = (ln >> 4) & 1;
        const int seg = u & 3, h = (u >> 2) & 7, b = u >> 5, n0 = seg * 32;
        const float l2g = log2gamma(h), g64 = fast_exp2(64.0f * l2g);
        const int drow = ln >> 3;
        const unsigned qk_src = (unsigned)(drow * RQK + (((ln & 7) ^ drow) << 3));
        const unsigned kt_src = (unsigned)(drow * RQK + (((ln & 7) ^ (((drow >> 1) & 1) << 2)) << 3));
        const unsigned v_src = (unsigned)((ln >> 4) * RVW + (((ln & 15) ^ (((ln >> 4) & 3) << 2)) << 3));
        const long tb = (long)b * SEQ + n0 * 64;
        const bf16* qg = F.QR() + tb * RQK + h * 64; const bf16* kg = F.KDR() + tb * RQK + h * 64; const bf16* vg = F.VR() + tb * RVW + h * 128;
#define R2_ISSUE(i_) do { const unsigned bo_ = lds_base + ((i_) & 1) * R2_BUF + w * 1024; const long ro_ = (long)(i_) * 64; \
        dma16_asm(qg + (ro_ + 8 * w) * RQK + qk_src, bo_); dma16_asm(kg + (ro_ + 8 * w) * RQK + qk_src, bo_ + 8192); dma16_asm(kg + (ro_ + 8 * w) * RQK + kt_src, bo_ + 16384); \
        dma16_asm(vg + (ro_ + 4 * w) * RVW + v_src, bo_ + 24576); dma16_asm(vg + (ro_ + 32 + 4 * w) * RVW + v_src, bo_ + 24576 + 8192); } while (0)
        R2_ISSUE(0);
        f32x16 acc[2];
#pragma unroll
        for (int r = 0; r < 16; ++r) { acc[0][r] = 0.f; acc[1][r] = 0.f; }
        { const float G = fast_exp2(2048.0f * l2g); float coef = 1.f;
          for (int sp = seg - 1; sp >= 0; --sp) {
              const int up = u - seg + sp;
              const f32x4* ee = (const f32x4*)F.ST() + ((long)((up * 2 + 0) * 4 + db) * 8) * 64 + ln; const f32x4* eo = (const f32x4*)F.ST() + ((long)((up * 2 + 1) * 4 + db) * 8) * 64 + ln;
#pragma unroll
              for (int jb = 0; jb < 2; ++jb)
#pragma unroll
                  for (int q4 = 0; q4 < 4; ++q4) { const f32x4 a = ee[(4 * jb + q4) * 64], c = eo[(4 * jb + q4) * 64];
                      acc[jb][4 * q4] += coef * (g64 * a[0] + c[0]); acc[jb][4 * q4 + 1] += coef * (g64 * a[1] + c[1]); acc[jb][4 * q4 + 2] += coef * (g64 * a[2] + c[2]); acc[jb][4 * q4 + 3] += coef * (g64 * a[3] + c[3]); }
              coef *= G;
          } }
        const float cr = fast_exp2(l2g * (float)(32 * th + r32 + 1));
        const int xq = l16 >> 2, x1 = (l16 & 3) >> 1, x0 = l16 & 1;
        const unsigned ka_off = (unsigned)((4 * hi + xq) * 128 + 8 * x0), ka_sw = (unsigned)(((l16 >> 3) & 1) << 2), ka_c = (unsigned)(2 * g16 + x1);
        const unsigned vrd = (unsigned)((l16 >> 2) * 256 + 8 * (l16 & 1)), vrsw = (unsigned)((l16 >> 2) << 2), vrc = (unsigned)(2 * g16 + ((l16 & 3) >> 1));
#pragma unroll 1
        for (int i = 0; i < 32; ++i) {
            asm volatile("s_waitcnt vmcnt(0)\n\ts_barrier" ::: "memory");
            if (i + 1 < 32) R2_ISSUE(i + 1);
            LAS unsigned char* bufp = lds + (i & 1) * R2_BUF;
            const long tq = (long)b * SEQ + (n0 + i) * 64 + 32 * th + r32;
            u32x4 gq[2];
#pragma unroll
            for (int gp = 0; gp < 2; ++gp) gq[gp] = *(const u32x4*)(F.GR() + tq * RVW + h * 128 + 32 * db + 16 * gp + 8 * hi);
            bf16x8 qf[4], pp[4];
            { const LAS unsigned char* qrow = bufp + (32 * th + r32) * 128 + 8 * hi;
#pragma unroll
              for (int s = 0; s < 4; ++s) { const u32x2 a = *(const LAS u32x2*)(qrow + (((2 * s) ^ (r32 & 7)) << 4)), c = *(const LAS u32x2*)(qrow + (((2 * s + 1) ^ (r32 & 7)) << 4));
                  const u32x4 t4 = {a.x, a.y, c.x, c.y}; qf[s] = __builtin_bit_cast(bf16x8, t4); } }
#pragma unroll
            for (int kb = 0; kb < 2; ++kb) {
                bf16x8 kf[4];
                const LAS unsigned char* krow = bufp + 8192 + (32 * kb + r32) * 128 + 8 * hi;
#pragma unroll
                for (int s = 0; s < 4; ++s) { const u32x2 a = *(const LAS u32x2*)(krow + (((2 * s) ^ (r32 & 7)) << 4)), c = *(const LAS u32x2*)(krow + (((2 * s + 1) ^ (r32 & 7)) << 4));
                    const u32x4 t4 = {a.x, a.y, c.x, c.y}; kf[s] = __builtin_bit_cast(bf16x8, t4); }
                f32x16 sa;
#pragma unroll
                for (int r = 0; r < 16; ++r) sa[r] = 0.f;
#pragma unroll
                for (int s = 0; s < 4; ++s) sa = MFMA32(kf[s], qf[s], sa);
#pragma unroll
                for (int r = 0; r < 16; ++r) { const int k = 32 * kb + (r & 3) + 8 * (r >> 2) + 4 * hi, q = 32 * th + r32; const int ad = q > k ? q - k : k - q;
                    sa[r] *= fast_exp2(l2g * (float)(ad - 63 + k)); }
                pp[2 * kb] = pack8(sa, 0); pp[2 * kb + 1] = pack8(sa, 8);
            }
            s16x4 vlo[4], vhi[4], al[2][4], ah[2][4];
            { const unsigned vb_ = lds_off(bufp) + 24576 + 4 * hi * 256 + vrd + (((4 * db + vrc) ^ vrsw) << 4);
              vlo[0] = lds_tr16o<0>(vb_); vhi[0] = lds_tr16o<2048>(vb_); vlo[1] = lds_tr16o<4096>(vb_); vhi[1] = lds_tr16o<6144>(vb_);
              vlo[2] = lds_tr16o<8192>(vb_); vhi[2] = lds_tr16o<10240>(vb_); vlo[3] = lds_tr16o<12288>(vb_); vhi[3] = lds_tr16o<14336>(vb_); }
#pragma unroll
            for (int jb = 0; jb < 2; ++jb) { const unsigned kb_ = lds_off(bufp) + 16384 + ka_off + (((4 * jb + ka_c) ^ ka_sw) << 4);
              al[jb][0] = lds_tr16o<0>(kb_); ah[jb][0] = lds_tr16o<1024>(kb_); al[jb][1] = lds_tr16o<2048>(kb_); ah[jb][1] = lds_tr16o<3072>(kb_);
              al[jb][2] = lds_tr16o<4096>(kb_); ah[jb][2] = lds_tr16o<5120>(kb_); al[jb][3] = lds_tr16o<6144>(kb_); ah[jb][3] = lds_tr16o<7168>(kb_); }
            TR_WAIT();
            f32x16 o, oc;
#pragma unroll
            for (int r = 0; r < 16; ++r) { o[r] = 0.f; oc[r] = 0.f; }
#pragma unroll
            for (int s4 = 0; s4 < 4; ++s4) {
                const bf16x8 vf = {vlo[s4][0], vlo[s4][1], vlo[s4][2], vlo[s4][3], vhi[s4][0], vhi[s4][1], vhi[s4][2], vhi[s4][3]};
                o = MFMA32(vf, pp[s4], o);
            }
#pragma unroll
            for (int s = 0; s < 4; ++s) oc = MFMA32(pack8(acc[s >> 1], 8 * (s & 1)), qf[s], oc);
#pragma unroll
            for (int r = 0; r < 16; ++r) o[r] += cr * oc[r];
#pragma unroll
            for (int r = 0; r < 16; ++r) { acc[0][r] *= g64; acc[1][r] *= g64; }
#pragma unroll
            for (int s4 = 0; s4 < 4; ++s4) {
                const bf16x8 vf = {vlo[s4][0], vlo[s4][1], vlo[s4][2], vlo[s4][3], vhi[s4][0], vhi[s4][1], vhi[s4][2], vhi[s4][3]};
#pragma unroll
                for (int jb = 0; jb < 2; ++jb) {
                    const bf16x8 afr = {al[jb][s4][0], al[jb][s4][1], al[jb][s4][2], al[jb][s4][3], ah[jb][s4][0], ah[jb][s4][1], ah[jb][s4][2], ah[jb][s4][3]};
                    acc[jb] = MFMA32(afr, vf, acc[jb]);
                }
            }
            float sum = 0.f, sq = 0.f;
#pragma unroll
            for (int r = 0; r < 16; ++r) { sum += o[r]; sq += o[r] * o[r]; }
            sum += __shfl_xor(sum, 32); sq += __shfl_xor(sq, 32);
            LAS f32x2_t* stt = (LAS f32x2_t*)(lds + R2_STAT);
            if (hi == 0) stt[w * 32 + r32] = (f32x2_t){sum, sq};
            asm volatile("s_waitcnt lgkmcnt(0)\n\ts_barrier" ::: "memory");
            float ts = 0.f, tq2 = 0.f;
#pragma unroll
            for (int d = 0; d < 4; ++d) { const f32x2_t v = stt[(th * 4 + d) * 32 + r32]; ts += v[0]; tq2 += v[1]; }
            const float mean = ts * (1.f / 128.f);
            const float rstd = 1.0f / sqrtf(fmaxf(tq2 * (1.f / 128.f) - mean * mean, 0.f) + 1e-5f);
#pragma unroll
            for (int gp = 0; gp < 2; ++gp) {
                const u32x4 q4 = gq[gp];
                const auto a0 = __builtin_amdgcn_permlane32_swap(q4.x, q4.z, false, false), a1 = __builtin_amdgcn_permlane32_swap(q4.y, q4.w, false, false);
                u32x2 wv[2];
#pragma unroll
                for (int e = 0; e < 2; ++e) { const int g = 2 * gp + e; const unsigned gx = a0[e], gy = a1[e];
                    wv[e].x = cvtpk((o[4 * g] - mean) * rstd * bf2f(gx & 0xffffu), (o[4 * g + 1] - mean) * rstd * bf2f(gx >> 16));
                    wv[e].y = cvtpk((o[4 * g + 2] - mean) * rstd * bf2f(gy & 0xffffu), (o[4 * g + 3] - mean) * rstd * bf2f(gy >> 16)); }
                const auto s0 = __builtin_amdgcn_permlane32_swap(wv[0].x, wv[1].x, false, false), s1 = __builtin_amdgcn_permlane32_swap(wv[0].y, wv[1].y, false, false);
                const u32x4 w4 = {s0[0], s1[0], s0[1], s1[1]};
                *(u32x4*)(F.ACAT() + tq * KCAT + AW + h * 128 + 32 * db + 16 * gp + 8 * hi) = w4;
            }
        }
#undef R2_ISSUE
        __syncthreads();
    }
}
__device__ __forceinline__ void p2_scan_ref(Frame& F) {
    const int gw = blockIdx.x * 8 + F.wave, NGW = F.G * 8, lane = F.lane;
    for (int it = gw; it < BATCH * 8 * 128; it += NGW) {
        const int dv = it & 127, h = (it >> 7) & 7, b = it >> 10;
        const float g64 = fast_exp2(64.0f * log2gamma(h));
        float st = 0.f;
        for (int n = 0; n < NCH; ++n) {
            F.ST()[(((size_t)(b * 8 + h) * NCH + n) * 128 + dv) * 64 + lane] = (bf16)f2bf(st);
            const size_t t0 = (size_t)b * SEQ + n * 64;
            float a = 0.f;
            for (int j = 0; j < 64; ++j) a += bf2f(F.KDR()[(t0 + j) * RQK + h * 64 + lane]) * bf2f(F.VR()[(t0 + j) * RVW + h * 128 + dv]);
            st = st * g64 + a;
        }
    }
}
__device__ __forceinline__ void p3_ret_ref(Frame& F) {
    const int gw = blockIdx.x * 8 + F.wave, NGW = F.G * 8, lane = F.lane;
    LAS float* sw = (LAS float*)(F.lds + F.wave * 16384);
    for (int it = gw; it < BATCH * NCH * 8; it += NGW) {
        const int h = it & 7, n = (it >> 3) & (NCH - 1), b = it >> 10;
        const size_t t0 = (size_t)b * SEQ + n * 64, t = t0 + lane;
        const float l2g = log2gamma(h);
        float q[64]; load_row64(F.QR() + t * RQK + h * 64, q);
        for (int j = 0; j < 64; ++j) {
            const float s = dot_row64(q, F.KDR() + (t0 + j) * RQK + h * 64);
            const int ad = lane > j ? lane - j : j - lane;
            sw[j * 64 + lane] = s * fast_exp2(l2g * (float)(ad - 63 + j));
        }
        asm volatile("s_waitcnt lgkmcnt(0)" ::: "memory");
        const float cross = fast_exp2(l2g * (float)(lane + 1));
        const bf16* stp = F.ST() + ((size_t)(b * 8 + h) * NCH + n) * 8192;
        float sum = 0.f, sq = 0.f, mean = 0.f, rstd = 0.f;
        for (int pass = 0; pass < 2; ++pass) {
#pragma unroll 1
            for (int dv = 0; dv < 128; ++dv) {
                float o = 0.f;
#pragma unroll 4
                for (int j = 0; j < 64; ++j) o += sw[j * 64 + lane] * bf2f(F.VR()[(t0 + j) * RVW + h * 128 + dv]);
                o += cross * dot_row64(q, stp + dv * 64);
                if (pass == 0) { sum += o; sq += o * o; }
                else F.ACAT()[t * KCAT + AW + h * 128 + dv] = (bf16)f2bf((o - mean) * rstd * F.gn_gain[h * 128 + dv] * bf2f(F.GR()[t * RVW + h * 128 + dv]));
            }
            if (pass == 0) { mean = sum * (1.f / 128.f); const float var = fmaxf(sq * (1.f / 128.f) - mean * mean, 0.f); rstd = 1.0f / sqrtf(var + 1e-5f); }
        }
        asm volatile("s_waitcnt lgkmcnt(0)" ::: "memory");
    }
}
__device__ __forceinline__ void p7_final_norm(Frame& F) {
    const int gw = blockIdx.x * 8 + F.wave, NGW = F.G * 8;
    for (int m = gw; m < T; m += NGW) {
        const f32x4* xr = (const f32x4*)(F.TMP() + (size_t)m * DM) + F.lane; f32x4* orow = (f32x4*)(F.out + (size_t)m * DM) + F.lane;
        const f32x4* gr = (const f32x4*)F.final_gain + F.lane;
        f32x4 v[4]; float s = 0.f;
#pragma unroll
        for (int j = 0; j < 4; ++j) { v[j] = xr[64 * j]; s += (v[j].x * v[j].x + v[j].y * v[j].y) + (v[j].z * v[j].z + v[j].w * v[j].w); }
        const float r = 1.0f / sqrtf(wave_sum(s) * (1.f / DM) + 1e-6f);
#pragma unroll
        for (int j = 0; j < 4; ++j) { const f32x4 g = gr[64 * j]; orow[64 * j] = v[j] * r * g; }
    }
}


typedef __attribute__((address_space(1))) unsigned gu32;
#define RLX_AGENT __ATOMIC_RELAXED, __HIP_MEMORY_SCOPE_AGENT
#define XB_TMO      128
#define XB_XCNT(j)  (256  + 64 * (j))
#define XB_XSUB(j)  (1280 + 64 * (j))
#define XB_XGEN(j)  (2304 + 64 * (j))
#define XB_TOP      3328
#define XB_TOPGEN   3392
#define XCD_BAR_WORDS 3456
#define XB_SPIN_CAP (1u << 18)

__device__ __forceinline__ unsigned xb_ld(unsigned* p)              { return __hip_atomic_load(p, __ATOMIC_RELAXED, __HIP_MEMORY_SCOPE_AGENT); }
__device__ __forceinline__ unsigned xb_add(unsigned* p, unsigned v) { return __hip_atomic_fetch_add(p, v, __ATOMIC_RELAXED, __HIP_MEMORY_SCOPE_AGENT); }
__device__ __forceinline__ unsigned xb_xcc_id() { return (unsigned)__builtin_amdgcn_s_getreg((3 << 11) | 20) & 0xFu; }
#define XB_SPIN(cond, bar) do { unsigned _sp = 0; while (cond) { __builtin_amdgcn_s_sleep(1); \
    if ((++_sp & 255u) == 0u) { if (xb_ld(&(bar)[XB_TMO])) break; if (_sp > XB_SPIN_CAP) { atomicAdd(&(bar)[XB_TMO], 1u); break; } } } } while (0)

struct XcdBarrier {
    unsigned* bar; unsigned x;
    volatile LAS unsigned* st;
};

__device__ __forceinline__ XcdBarrier xcd_barrier_post(unsigned* bar, volatile LAS unsigned* st, bool leader) {
    XcdBarrier b; b.bar = bar; b.x = xb_xcc_id(); b.st = st;
    if (leader) (void)xb_add(&bar[XB_XCNT(b.x)], 1u);
    return b;
}
__device__ __forceinline__ void xcd_barrier_complete(unsigned* bar, unsigned x, unsigned& nloc, unsigned& nx) {
    const unsigned G = gridDim.x * gridDim.y * gridDim.z;
    unsigned sum, cnt, mine, sp = 0u;
    for (;;) {
        sum = 0u; cnt = 0u; mine = 0u;
#pragma unroll
        for (unsigned j = 0; j < 16; ++j) { const unsigned c = xb_ld(&bar[XB_XCNT(j)]); sum += c; cnt += (c > 0u) ? 1u : 0u; mine = (j == x) ? c : mine; }
        if (sum == G) break;
        __builtin_amdgcn_s_sleep(1);
        if ((++sp & 255u) == 0u) { if (xb_ld(&bar[XB_TMO])) break; if (sp > XB_SPIN_CAP) { atomicAdd(&bar[XB_TMO], 1u); break; } }
    }
    nloc = mine > 0u ? mine : 1u; nx = cnt > 0u ? cnt : 1u;
}

__device__ __forceinline__ void xcd_barrier(const XcdBarrier& b, bool leader) {
    asm volatile("s_waitcnt vmcnt(0)" ::: "memory");
    __syncthreads();
    if (leader) {
        unsigned* bar = b.bar;
        __builtin_amdgcn_s_waitcnt(0);
        unsigned nloc = b.st[0], nx = b.st[1];
        if (nloc == 0u) { xcd_barrier_complete(bar, b.x, nloc, nx); b.st[0] = nloc; b.st[1] = nx; }
        const unsigned old = xb_add(&bar[XB_XSUB(b.x)], 1u);
        const unsigned gen = old / nloc;
        if (old + 1u == (gen + 1u) * nloc) {
            __builtin_amdgcn_fence(__ATOMIC_RELEASE, "agent");
            asm volatile("s_waitcnt vmcnt(0)" ::: "memory");
            const unsigned og = xb_add(&bar[XB_TOP], 1u);
            const unsigned tg = og / nx;
            if (og + 1u == (tg + 1u) * nx) xb_add(&bar[XB_TOPGEN], 1u);
            else XB_SPIN(xb_ld(&bar[XB_TOPGEN]) == tg, bar);
            __builtin_amdgcn_fence(__ATOMIC_ACQUIRE, "agent");
            xb_add(&bar[XB_XGEN(b.x)], 1u);
            asm volatile("s_waitcnt vmcnt(0)" ::: "memory");
        } else {
            XB_SPIN(xb_ld(&bar[XB_XGEN(b.x)]) == gen, bar);
            __builtin_amdgcn_fence(__ATOMIC_ACQUIRE, "agent");
            asm volatile("s_waitcnt vmcnt(0)" ::: "memory");
        }
    }
    __syncthreads();
}


constexpr int MISC_OFF = 155136;

__global__ void __launch_bounds__(512, 2) fwd(Args args) {
    extern __shared__ __attribute__((aligned(16))) unsigned char lds[];
    Frame F;
    F.lds = (LAS unsigned char*)lds;
    F.tid = threadIdx.x; F.lane = F.tid & 63; F.wave = __builtin_amdgcn_readfirstlane(F.tid >> 6); F.G = gridDim.x;
    F.x = args.in[0]; F.norm_gain = args.in[1]; F.w_in = args.in[2]; F.rel_bias = args.in[3]; F.gn_gain = args.in[4];
    F.w_out_attn = args.in[5]; F.w_out_ret = args.in[6]; F.w_out = args.in[7]; F.final_gain = args.in[8]; F.out = args.out;
    unsigned char* ws = args.ws; F.ws = ws;
    volatile LAS unsigned* MISC = (volatile LAS unsigned*)(F.lds + MISC_OFF);
    if (F.tid < 32) MISC[F.tid] = 0u;
    __syncthreads();
    XcdBarrier bar = xcd_barrier_post((unsigned*)(ws + WS_CTL) + 4096, MISC + 8, F.tid == 0);
#define GRID_BAR() do { const int t_ = (F.wave << 6) | lane_id_asm(); xcd_barrier(bar, t_ == 0); { unsigned long w_ = (unsigned long)args.ws; asm volatile("" : "+s"(w_)); F.ws = (unsigned char*)(__attribute__((address_space(1))) unsigned char*)w_; F.tid = t_; F.lane = t_ & 63; } } while (0)
    p0_prologue(F); GRID_BAR();
    { pg8::Gemm g{F.H(), F.WinT(), T, 20 * 256, DM, DM, DM}; pg8::StaticOrder S; S.init(T, 20 * 256, F.G, (int)blockIdx.x);
      Epi1 E{F.QA(), F.KA(), F.VA(), F.GA(), F.QR(), F.KDR(), F.VR(), F.GR(), F.SA(), F.SR(), 0, F.gn_gain};
      pg8::gemm_phase<Epi1, pg8::StaticOrder, true, true>(F.lds, g, S, E, F.wave); }
    GRID_BAR();
    if (((int)blockIdx.x >> 7) == 0) { p2_seg_state(F); p5_attn_mfma(F); }
    else { p5_attn_mfma(F); __syncthreads(); p2_seg_state(F); }
    GRID_BAR();
#define GATE_GEMM() do { pg8::Gemm g{F.H(), F.WinT() + (size_t)20 * 256 * DM, T, 8 * 256, DM, DM, DM}; pg8::StaticOrder S; S.init(T, 8 * 256, F.G, (int)blockIdx.x); \
      Epi1 E{F.QA(), F.KA(), F.VA(), F.GA(), F.QR(), F.KDR(), F.VR(), F.GR(), F.SA(), F.SR(), 20, F.gn_gain}; \
      pg8::gemm_phase<Epi1, pg8::StaticOrder, true, true>(F.lds, g, S, E, F.wave); } while (0)
    if ((((int)blockIdx.x >> 3) & 1) == 0) { p3_ret2(F); __syncthreads(); GATE_GEMM(); }
    else { GATE_GEMM(); __syncthreads(); p3_ret2(F); }
#undef GATE_GEMM
    GRID_BAR();
    { pg8::Gemm g{F.ACAT(), F.WcatT(), T, DM, KCAT, KCAT, KCAT}; pg8::StaticOrder S; S.init(T, DM, F.G, (int)blockIdx.x);
      Epi2 E{F.SA(), F.SR(), F.MIXED()};
      pg8::gemm_phase<Epi2, pg8::StaticOrder, true, true>(F.lds, g, S, E, F.wave); }
    GRID_BAR();
    { pg8::Gemm g{F.MIXED(), F.WoT(), T, DM, DM, DM, DM}; pg8::StaticOrder S; S.init(T, DM, F.G, (int)blockIdx.x);
      Epi3n E{F.x, F.out, F.final_gain, (float*)(F.ws + WS_XBUF), (unsigned*)(F.ws + WS_CTL) + CW_PANEL, F.lds};
      pg8::gemm_phase<Epi3n, pg8::StaticOrder, true, true>(F.lds, g, S, E, F.wave); }
#undef GRID_BAR
}

extern "C" void kernel_launch(void* const* d_in, const int* in_sizes, int n_in, void* d_out, int out_size, void* d_ws, size_t ws_size, hipStream_t stream) {
    static int grid = 0;
    if (grid == 0) {
        if (n_in != 9 || in_sizes[0] != T * DM || out_size != T * DM || ws_size < WS_END) { fprintf(stderr, "kernel_launch: unexpected shapes / workspace (n_in %d, in0 %d, out %d, ws %zu); nothing launched\n", n_in, n_in > 0 ? in_sizes[0] : -1, out_size, ws_size); grid = -1; return; }
        int dev = 0, cus = 0;
        if (hipGetDevice(&dev) != hipSuccess || hipDeviceGetAttribute(&cus, hipDeviceAttributeMultiprocessorCount, dev) != hipSuccess) { grid = -1; return; }
        if (hipFuncSetAttribute((const void*)fwd, hipFuncAttributeMaxDynamicSharedMemorySize, LDS_BYTES) != hipSuccess) { fprintf(stderr, "kernel_launch: hipFuncSetAttribute failed\n"); grid = -1; return; }
        (void)hipGetLastError();
        grid = cus;
    }
    if (grid < 0) return;
    if (hipMemsetAsync((char*)d_ws + WS_CTL, 0, 1 * MiB, stream) != hipSuccess) return;
    Args a{};
    for (int i = 0; i < 9; ++i) a.in[i] = (const float*)d_in[i];
    a.out = (float*)d_out; a.ws = (unsigned char*)d_ws;
    hipLaunchKernelGGL(fwd, dim3(grid), dim3(512), LDS_BYTES, stream, a);
}
```
